# Optimizing an MI355X kernel written in HIP

```python
import math
import jax, jax.numpy as jnp
from jax import lax
import numpy as np

D_MODEL = 1024
BATCH = 8
SEQ = 2048
DEPTH = 2
DEC_BATCH = 128
DEC_SEQ = 8
PAST_LEN = 16384
PAGE_SIZE = 128

N_MIXERS = 2
N_POOL_LAYERS = (DEPTH + 1) // 2
N_SSM_LAYERS = DEPTH // 2
POOL_WINDOWS = (2, 4, 8, 16)
POOL_GROUPS = len(POOL_WINDOWS)
POOL_GC = D_MODEL // POOL_GROUPS
POOL_MAX = 16
POOL_STATE = POOL_MAX - 1
SSM_GC = 16
SSM_GROUPS = D_MODEL // SSM_GC
SSM_P = 64
FFN_HIDDEN = 2816
FFN_UP = 2 * FFN_HIDDEN
CONV_W = 3
EPS = 1e-6

kernel_name = "hybrid_pool_s5_convffn_step"


def rmsnorm(x, g):
    xf = x.astype(jnp.float32)
    return xf * lax.rsqrt(jnp.mean(xf * xf, axis=-1, keepdims=True) + EPS) * g.astype(jnp.float32)


def ada_mod(c, w, b):
    m = jax.nn.silu(c.astype(jnp.float32)) @ w.astype(jnp.float32) + b.astype(jnp.float32)
    return jnp.split(m, 6, axis=-1)


def pre_mod(x, g, shift, scale):
    return (rmsnorm(x, g) * (1.0 + scale[:, None, :]) + shift[:, None, :]).astype(x.dtype)


def gated_residual(x, m, g, gate):
    return x + (gate[:, None, :] * rmsnorm(m, g)).astype(x.dtype)


def pool_mix(h_ext, n_prev, pos0, w_pool, pool_scale):
    Bsz, Le, D = h_ext.shape
    L = Le - n_prev
    hf = h_ext.astype(jnp.float32)
    cs = jnp.cumsum(jnp.pad(hf, ((0, 0), (POOL_MAX, 0), (0, 0))), axis=1)
    pos = pos0 + jnp.arange(n_prev, Le)
    parts = []
    for g, w in enumerate(POOL_WINDOWS):
        sl = slice(g * POOL_GC, (g + 1) * POOL_GC)
        hi = cs[:, POOL_MAX + n_prev:POOL_MAX + Le, sl]
        lo = cs[:, POOL_MAX + n_prev - w:POOL_MAX + Le - w, sl]
        cnt = jnp.minimum(pos + 1, w).astype(jnp.float32)[None, :, None]
        parts.append((hi - lo) / cnt - hf[:, n_prev:, sl])
    pooled = jnp.stack(parts, axis=2)
    y = jnp.einsum('blgc,gcd->blgd', pooled, w_pool.astype(jnp.float32)).reshape(Bsz, L, D)
    return y * pool_scale.astype(jnp.float32)


def _cmul_combine(e1, e2):
    a1r, a1i, b1r, b1i = e1
    a2r, a2i, b2r, b2i = e2
    ar = a2r * a1r - a2i * a1i
    ai = a2r * a1i + a2i * a1r
    br = a2r * b1r - a2i * b1i + b2r
    bi = a2r * b1i + a2i * b1r + b2i
    return (ar, ai, br, bi)


def s5_mix(u, x0_re, x0_im, A_re, A_im, log_dt, B_re, B_im, C_re, C_im, D_skip, w_glu_a, w_glu_b):
    f32 = jnp.float32
    Bsz, L, D = u.shape
    uf = u.astype(f32).reshape(Bsz, L, SSM_GROUPS, SSM_GC)
    A_re = A_re.astype(f32); A_im = A_im.astype(f32)
    dt = jnp.exp(log_dt.astype(f32))[:, None]
    mag = jnp.exp(A_re * dt); ang = A_im * dt
    lb_re = mag * jnp.cos(ang); lb_im = mag * jnp.sin(ang)
    n_re = lb_re - 1.0; n_im = lb_im
    den = A_re * A_re + A_im * A_im
    f_re = (n_re * A_re + n_im * A_im) / den
    f_im = (n_im * A_re - n_re * A_im) / den
    B_re = B_re.astype(f32); B_im = B_im.astype(f32)
    Bb_re = f_re[..., None] * B_re - f_im[..., None] * B_im
    Bb_im = f_re[..., None] * B_im + f_im[..., None] * B_re
    bu_re = jnp.einsum('blgc,gpc->blgp', uf, Bb_re)
    bu_im = jnp.einsum('blgc,gpc->blgp', uf, Bb_im)
    x0_re = x0_re.astype(f32); x0_im = x0_im.astype(f32)
    bu_re = bu_re.at[:, 0].add(lb_re * x0_re - lb_im * x0_im)
    bu_im = bu_im.at[:, 0].add(lb_re * x0_im + lb_im * x0_re)
    a_re = jnp.broadcast_to(lb_re, bu_re.shape)
    a_im = jnp.broadcast_to(lb_im, bu_im.shape)
    _, _, s_re, s_im = lax.associative_scan(_cmul_combine, (a_re, a_im, bu_re, bu_im), axis=1)
    y = (jnp.einsum('blgp,gcp->blgc', s_re, C_re.astype(f32))
         - jnp.einsum('blgp,gcp->blgc', s_im, C_im.astype(f32))
         + D_skip.astype(f32).reshape(SSM_GROUPS, SSM_GC) * uf).reshape(Bsz, L, D)
    g = jax.nn.gelu(y, approximate=False)
    out = (g @ w_glu_a.astype(f32)) * jax.nn.sigmoid(g @ w_glu_b.astype(f32))
    return out, s_re[:, -1], s_im[:, -1]


def conv_ffn(h, conv_prev, w_up, conv_w, conv_b, w_down):
    L = h.shape[1]
    up = h @ w_up
    ext = jnp.concatenate([conv_prev.astype(up.dtype), up], axis=1)
    conv = conv_b
    for k in range(CONV_W):
        conv = conv + ext[:, k:k + L] * conv_w[k]
    gate, val = jnp.split(conv, 2, axis=-1)
    out = (jax.nn.gelu(gate, approximate=False) * val) @ w_down
    return out, ext[:, -(CONV_W - 1):]


def setup_inputs(seed: int = 0) -> dict:
    key = jax.random.key(seed)
    ks = jax.random.split(key, 32)
    nrm = jax.random.normal
    f32 = jnp.float32
    D = D_MODEL
    d = {}
    d["x_prompt"] = nrm(ks[0], (BATCH, SEQ, D), f32)
    d["x_sample"] = nrm(ks[1], (DEC_BATCH, DEC_SEQ, D), f32)
    d["c_prompt"] = nrm(ks[2], (BATCH, D), f32)
    d["c_sample"] = nrm(ks[3], (DEC_BATCH, D), f32)
    d["state_pool"] = nrm(ks[4], (N_POOL_LAYERS, DEC_BATCH, POOL_STATE, D), f32)
    d["state_ssm_re"] = 0.1 * nrm(ks[5], (N_SSM_LAYERS, DEC_BATCH, SSM_GROUPS, SSM_P), f32)
    d["state_ssm_im"] = 0.1 * nrm(ks[6], (N_SSM_LAYERS, DEC_BATCH, SSM_GROUPS, SSM_P), f32)
    d["state_ffn_conv"] = 0.5 * nrm(ks[7], (DEPTH, DEC_BATCH, CONV_W - 1, FFN_UP), f32)
    d["ada_w"] = nrm(ks[8], (DEPTH, D, 6 * D), f32) * (0.5 * D ** -0.5)
    d["ada_b"] = 0.02 * nrm(ks[9], (DEPTH, 6 * D), f32)
    d["mix_pre_g"] = 1.0 + 0.02 * nrm(ks[10], (DEPTH, D), f32)
    d["mix_post_g"] = 1.0 + 0.02 * nrm(ks[11], (DEPTH, D), f32)
    d["ffn_pre_g"] = 1.0 + 0.02 * nrm(ks[12], (DEPTH, D), f32)
    d["ffn_post_g"] = 1.0 + 0.02 * nrm(ks[13], (DEPTH, D), f32)
    d["pool_w"] = nrm(ks[14], (N_POOL_LAYERS, POOL_GROUPS, POOL_GC, POOL_GC), f32) * POOL_GC ** -0.5
    d["pool_scale"] = 1.0 + 0.02 * nrm(ks[15], (N_POOL_LAYERS, D), f32)
    d["ssm_A_re"] = -0.5 + 0.01 * nrm(ks[16], (N_SSM_LAYERS, SSM_GROUPS, SSM_P), f32)
    d["ssm_A_im"] = math.pi * jnp.arange(SSM_P, dtype=f32) + 0.01 * nrm(ks[17], (N_SSM_LAYERS, SSM_GROUPS, SSM_P), f32)
    d["ssm_log_dt"] = jax.random.uniform(ks[18], (N_SSM_LAYERS, SSM_GROUPS), f32, math.log(1e-3), math.log(1e-1))
    d["ssm_B_re"] = nrm(ks[19], (N_SSM_LAYERS, SSM_GROUPS, SSM_P, SSM_GC), f32) * (2 * SSM_GC) ** -0.5
    d["ssm_B_im"] = nrm(ks[20], (N_SSM_LAYERS, SSM_GROUPS, SSM_P, SSM_GC), f32) * (2 * SSM_GC) ** -0.5
    d["ssm_C_re"] = nrm(ks[21], (N_SSM_LAYERS, SSM_GROUPS, SSM_GC, SSM_P), f32) * SSM_P ** -0.5
    d["ssm_C_im"] = nrm(ks[22], (N_SSM_LAYERS, SSM_GROUPS, SSM_GC, SSM_P), f32) * SSM_P ** -0.5
    d["ssm_D"] = nrm(ks[23], (N_SSM_LAYERS, D), f32)
    d["ssm_glu_a"] = nrm(ks[24], (N_SSM_LAYERS, D, D), f32) * D ** -0.5
    d["ssm_glu_b"] = nrm(ks[25], (N_SSM_LAYERS, D, D), f32) * D ** -0.5
    d["ffn_w_up"] = nrm(ks[26], (DEPTH, D, FFN_UP), f32) * D ** -0.5
    d["ffn_conv_w"] = nrm(ks[27], (DEPTH, CONV_W, FFN_UP), f32) * CONV_W ** -0.5
    d["ffn_conv_b"] = 0.02 * nrm(ks[28], (DEPTH, FFN_UP), f32)
    d["ffn_w_down"] = nrm(ks[29], (DEPTH, FFN_HIDDEN, D), f32) * FFN_HIDDEN ** -0.5
    return d


def reference(x_prompt, x_sample, c_prompt, c_sample, state_pool, state_ssm_re, state_ssm_im,
              state_ffn_conv, ada_w, ada_b, mix_pre_g, mix_post_g, ffn_pre_g, ffn_post_g,
              pool_w, pool_scale, ssm_A_re, ssm_A_im, ssm_log_dt, ssm_B_re, ssm_B_im,
              ssm_C_re, ssm_C_im, ssm_D, ssm_glu_a, ssm_glu_b,
              ffn_w_up, ffn_conv_w, ffn_conv_b, ffn_w_down):
    yp, ys = x_prompt, x_sample
    pool_p, pool_s, sre_p, sim_p, sre_s, sim_s, conv_p, conv_s = [], [], [], [], [], [], [], []
    for l in range(DEPTH):
        sh1p, sc1p, g1p, sh2p, sc2p, g2p = ada_mod(c_prompt, ada_w[l], ada_b[l])
        sh1s, sc1s, g1s, sh2s, sc2s, g2s = ada_mod(c_sample, ada_w[l], ada_b[l])
        hp = pre_mod(yp, mix_pre_g[l], sh1p, sc1p)
        hs = pre_mod(ys, mix_pre_g[l], sh1s, sc1s)
        j = l // N_MIXERS
        if l % N_MIXERS == 0:
            mp = pool_mix(hp, 0, 0, pool_w[j], pool_scale[j])
            hs_ext = jnp.concatenate([state_pool[j].astype(hs.dtype), hs], axis=1)
            ms = pool_mix(hs_ext, POOL_STATE, PAST_LEN - POOL_STATE, pool_w[j], pool_scale[j])
            pool_p.append(hp[:, -POOL_STATE:])
            pool_s.append(hs_ext[:, -POOL_STATE:])
        else:
            z0 = jnp.zeros((hp.shape[0], SSM_GROUPS, SSM_P), jnp.float32)
            mp, lr_p, li_p = s5_mix(hp, z0, z0, ssm_A_re[j], ssm_A_im[j], ssm_log_dt[j], ssm_B_re[j],
                                    ssm_B_im[j], ssm_C_re[j], ssm_C_im[j], ssm_D[j], ssm_glu_a[j], ssm_glu_b[j])
            ms, lr_s, li_s = s5_mix(hs, state_ssm_re[j], state_ssm_im[j], ssm_A_re[j], ssm_A_im[j], ssm_log_dt[j],
                                    ssm_B_re[j], ssm_B_im[j], ssm_C_re[j], ssm_C_im[j], ssm_D[j],
                                    ssm_glu_a[j], ssm_glu_b[j])
            sre_p.append(lr_p.astype(state_ssm_re.dtype)); sim_p.append(li_p.astype(state_ssm_im.dtype))
            sre_s.append(lr_s.astype(state_ssm_re.dtype)); sim_s.append(li_s.astype(state_ssm_im.dtype))
        yp = gated_residual(yp, mp, mix_post_g[l], g1p)
        ys = gated_residual(ys, ms, mix_post_g[l], g1s)
        fp = pre_mod(yp, ffn_pre_g[l], sh2p, sc2p)
        fs = pre_mod(ys, ffn_pre_g[l], sh2s, sc2s)
        zc = jnp.zeros((fp.shape[0], CONV_W - 1, FFN_UP), fp.dtype)
        op, cp = conv_ffn(fp, zc, ffn_w_up[l], ffn_conv_w[l], ffn_conv_b[l], ffn_w_down[l])
        os_, cs_ = conv_ffn(fs, state_ffn_conv[l], ffn_w_up[l], ffn_conv_w[l], ffn_conv_b[l], ffn_w_down[l])
        conv_p.append(cp); conv_s.append(cs_)
        yp = gated_residual(yp, op, ffn_post_g[l], g2p)
        ys = gated_residual(ys, os_, ffn_post_g[l], g2s)
    new_pool_prompt = jnp.stack(pool_p, axis=0)
    new_pool_sample = jnp.stack(pool_s, axis=0)
    new_ssm_re_prompt = jnp.stack(sre_p, axis=0)
    new_ssm_im_prompt = jnp.stack(sim_p, axis=0)
    new_ssm_re_sample = jnp.stack(sre_s, axis=0)
    new_ssm_im_sample = jnp.stack(sim_s, axis=0)
    new_conv_prompt = jnp.stack(conv_p, axis=0)
    new_conv_sample = jnp.stack(conv_s, axis=0)
    return (yp, ys, new_pool_prompt, new_pool_sample, new_ssm_re_prompt, new_ssm_im_prompt,
            new_ssm_re_sample, new_ssm_im_sample, new_conv_prompt, new_conv_sample)
```

```cpp
#include <hip/hip_runtime.h>
#include <hip/hip_cooperative_groups.h>
#include <cstdio>
#include <cstdint>
namespace cg = cooperative_groups;

#define LAS __attribute__((address_space(3)))
typedef unsigned short bf16_t;
typedef short bf16x8 __attribute__((ext_vector_type(8)));
typedef float f32x4 __attribute__((ext_vector_type(4)));
typedef float f32x2 __attribute__((ext_vector_type(2)));
typedef float f32x16 __attribute__((ext_vector_type(16)));
typedef unsigned u32x4 __attribute__((ext_vector_type(4)));
typedef unsigned u32x2 __attribute__((ext_vector_type(2)));

constexpr int D = 1024, NPR = 16384, NSR = 1024, MROWS = NPR + NSR, FH = 2816, FU = 5632;
constexpr int SEQ = 2048, NCB = 136;
constexpr float EPS = 1e-6f;
constexpr int NMT = MROWS / 256;
constexpr size_t O_Y = 0, O_POOLP = 17825792, O_POOLS = O_POOLP + 122880, O_SREP = O_POOLS + 1966080, O_SIMP = O_SREP + 32768,
                 O_SRES = O_SIMP + 32768, O_SIMS = O_SRES + 524288, O_CONVP = O_SIMS + 524288, O_CONVS = O_CONVP + 180224;
constexpr size_t MiB = 1u << 20;
constexpr size_t WS_CTL = 0, CTL_ZERO_BYTES = 65536;
constexpr size_t WS_WUP = 1 * MiB, WS_WDN = 23 * MiB, WS_WGLU = 34 * MiB, WS_WPOOL = 38 * MiB, WS_AADA = 38 * MiB + 512 * 1024, WS_MOD = 39 * MiB;
constexpr size_t WS_SMALL = 46 * MiB, WS_BBT = WS_SMALL, WS_CMT = WS_BBT + 262144, WS_LBR = WS_CMT + 327680, WS_LBI = WS_LBR + 16384, WS_RSTD0 = WS_LBI + 16384;
constexpr size_t WS_BND = 47 * MiB, WS_ABUF = 54 * MiB, WS_MBUF = 88 * MiB, WS_ACT = 122 * MiB, WS_ADAT = 122 * MiB, WS_ABUF2 = 146 * MiB;
constexpr size_t WS_PART = WS_ABUF;
constexpr size_t WS_PARTG = 186 * MiB;
constexpr size_t WS_YB = 216 * MiB;
constexpr size_t WS_END = 250 * MiB;
constexpr int NKS = 11, NKG = 4;
constexpr int CW_BAR = 1024;
constexpr int RING_BYTES = 131072, XCH_OFF = 131072, XCH_BYTES = 8192, MISC_OFF = XCH_OFF + XCH_BYTES, LDS_BYTES = MISC_OFF + 256;
constexpr int S5_LD = 132, S5_WAVE_BYTES = 32 * S5_LD * 4;
static_assert(8 * S5_WAVE_BYTES <= MISC_OFF, "s5 lds");

__device__ __forceinline__ unsigned cvt_pk_bf16(float lo, float hi) { unsigned r; asm volatile("v_cvt_pk_bf16_f32 %0, %1, %2" : "=v"(r) : "v"(lo), "v"(hi)); return r; }
__device__ __forceinline__ f32x4 ldnt4(const float* p) { return __builtin_nontemporal_load((const f32x4*)p); }
__device__ __forceinline__ u32x2 ldnt2u(const bf16_t* p) { return __builtin_nontemporal_load((const u32x2*)p); }
__device__ __forceinline__ void stnt4(float* p, f32x4 v) { __builtin_nontemporal_store(v, (f32x4*)p); }
__device__ __forceinline__ float bf2f(unsigned short b) { return __builtin_bit_cast(float, (unsigned)b << 16); }
__device__ __forceinline__ float wave_sum(float v) {
#pragma unroll
    for (int o = 1; o < 64; o <<= 1) v += __shfl_xor(v, o);
    return v;
}
__device__ __forceinline__ f32x2 gelu_pk(f32x2 v) {
    const f32x2 av = __builtin_elementwise_abs(v), d = av * 0.2316418882f + 1.0f;
    f32x2 t; t.x = __builtin_amdgcn_rcpf(d.x); t.y = __builtin_amdgcn_rcpf(d.y);
    f32x2 q = t * 0.5307027145f + (-0.7265760135f); q = q * t + 0.7107068705f; q = q * t + (-0.142248368f); q = q * t + 0.127414796f; q = q * t;
    const f32x2 s = (v * v) * (-0.72134752044f);
    f32x2 e; e.x = __builtin_amdgcn_exp2f(s.x); e.y = __builtin_amdgcn_exp2f(s.y);
    const f32x2 m = v * (q * e), r = v - m;
    f32x2 o; o.x = v.x < 0.f ? m.x : r.x; o.y = v.y < 0.f ? m.y : r.y; return o;
}
__device__ __forceinline__ float gelu1(float x) { f32x2 r = gelu_pk((f32x2){x, 0.f}); return r.x; }
__device__ __forceinline__ float sigmoidf_(float x) { return __builtin_amdgcn_rcpf(1.0f + __builtin_amdgcn_exp2f(x * -1.44269504089f)); }
__device__ __forceinline__ float dpp_ror1(float x) { return __builtin_bit_cast(float, __builtin_amdgcn_update_dpp(0, __builtin_bit_cast(int, x), 0x121, 0xF, 0xF, false)); }
__device__ __forceinline__ float dpp_ror2(float x) { return __builtin_bit_cast(float, __builtin_amdgcn_update_dpp(0, __builtin_bit_cast(int, x), 0x122, 0xF, 0xF, false)); }
__device__ __forceinline__ float dpp_shr1z(float x) { return __builtin_bit_cast(float, __builtin_amdgcn_update_dpp(0, __builtin_bit_cast(int, x), 0x111, 0xF, 0xF, true)); }
__device__ __forceinline__ f32x4 shr1z(f32x4 v) { return (f32x4){dpp_shr1z(v[0]), dpp_shr1z(v[1]), dpp_shr1z(v[2]), dpp_shr1z(v[3])}; }
__device__ __forceinline__ f32x4 ror1v(f32x4 v) { return (f32x4){dpp_ror1(v[0]), dpp_ror1(v[1]), dpp_ror1(v[2]), dpp_ror1(v[3])}; }
__device__ __forceinline__ f32x4 ror2v(f32x4 v) { return (f32x4){dpp_ror2(v[0]), dpp_ror2(v[1]), dpp_ror2(v[2]), dpp_ror2(v[3])}; }

typedef const float* __attribute__((address_space(4))) const* karg_tab_t;
typedef const __attribute__((address_space(4))) unsigned char* kp_t;
#define KP_LAUNDER() asm volatile("" : "+s"(kp))
#define KIN(i) ((const float*)(((karg_tab_t)kp)[i]))
#define KOUT() ((float*)(((karg_tab_t)kp)[30]))
#define KWS() ((unsigned char*)(((karg_tab_t)kp)[31]))
#define WSP(T, off) ((T*)(KWS() + (off)))
enum { I_XP = 0, I_XS, I_CP, I_CS, I_SPOOL, I_SSRE, I_SSIM, I_SCONV, I_ADAW, I_ADAB, I_MPREG, I_MPOSTG, I_FPREG, I_FPOSTG, I_POOLW, I_POOLSC,
       I_ARE, I_AIM, I_LOGDT, I_BRE, I_BIM, I_CRE, I_CIM, I_SD, I_GLUA, I_GLUB, I_WUP, I_CONVW, I_CONVB, I_WDN };
__device__ __forceinline__ int hw_lane() { return (int)__builtin_amdgcn_mbcnt_hi(~0u, __builtin_amdgcn_mbcnt_lo(~0u, 0u)); }
namespace pg8 {
constexpr int BM = 256, BK = 64, HALF = 128, HTB = HALF * BK * 2, NXCD = 8, WGM = 8;
__host__ __device__ __forceinline__ int lds_byte(int r, int c) { const int st = (r >> 4) * 2 + (c >> 5), rr = r & 15, cc = c & 31, ob = rr * 64 + cc * 2; return st * 1024 + (ob ^ (((ob >> 9) & 1) << 5)); }
__host__ __device__ __forceinline__ void stage_rc(int b, int& R, int& C) { const int st = b / 1024, sb = b % 1024, swz = sb ^ (((sb >> 9) & 1) << 5); R = (st >> 1) * 16 + swz / 64; C = (st & 1) * 32 + (swz % 64) / 2; }
__host__ __device__ __forceinline__ int perm32(int rho) { const int n = rho >> 4, i = rho & 15; return 8 * (i >> 2) + 4 * n + (i & 3); }
struct Unit { int pm, pn, ks; };
struct Gemm { const bf16_t* A; const bf16_t* Bt; int K, lda, ldb, a_pn_off, k_slice; };
struct StaticOrder {
    int nM, nN, nwg, G, c;
    __device__ void init(int M, int N, int G_, int c_) { nM = M / BM; nN = N / BM; nwg = nM * nN; G = G_; c = c_; }
    __device__ bool next(int i, Unit& u) const {
        const long L = (long)i * G + c; if (L >= nwg) return false;
        int wgid = (int)L; { const int q = nwg / NXCD, r = nwg % NXCD, xcd = wgid % NXCD, off = wgid / NXCD; wgid = (xcd < r ? xcd * (q + 1) : r * (q + 1) + (xcd - r) * q) + off; }
        const int nig = WGM * nN, gid = wgid / nig, fm = gid * WGM, gsz = (nM - fm) < WGM ? (nM - fm) : WGM;
        u.pm = fm + ((wgid % nig) % gsz); u.pn = (wgid % nig) / gsz; u.ks = 0; return true;
    }
};
template <int NS, int NN>
struct SliceOrder {
    int c;
    __device__ bool next(int i, Unit& u) const { if (i != 0 || c >= 4 * NN * NS) return false; const int su = c / NS; u.pm = 64 + su / NN; u.pn = su % NN; u.ks = c % NS; return true; }
};

struct EpiAda {
    static constexpr bool PERM = false;
    kp_t kp0;
    __device__ __forceinline__ void operator()(const f32x4 (&acc)[2][2][4][2], const Unit& u, int wr, int wc, int fr, int fq, LAS unsigned char*) const {
        kp_t kp = kp0; KP_LAUNDER();
        const float* bias = KIN(I_ADAB);
        int colt = u.pn * BM; const int t = colt / 6144; float* base = WSP(float, WS_MOD) + (size_t)t * NCB * 6144; colt -= t * 6144;
#pragma unroll
        for (int bj = 0; bj < 2; ++bj)
#pragma unroll
            for (int n = 0; n < 2; ++n) {
                const int cl = bj * HALF + wc * 32 + n * 16 + 4 * fq;
                const f32x4 bv = *(const f32x4*)(bias + u.pn * BM + cl);
#pragma unroll
                for (int ai = 0; ai < 2; ++ai)
#pragma unroll
                    for (int m = 0; m < 4; ++m) {
                        const int row = u.pm * BM + ai * HALF + wr * 64 + m * 16 + fr;
                        if (row < NCB) *(f32x4*)(base + (size_t)row * 6144 + colt + cl) = acc[ai][bj][m][n] + bv;
                    }
            }
    }
};
struct EpiBf16 {
    static constexpr bool PERM = true;
    kp_t kp0; int mode;
    __device__ __forceinline__ void operator()(const f32x4 (&acc)[2][2][4][2], const Unit& u, int wr, int wc, int fr, int fq, LAS unsigned char*) const {
        kp_t kp = kp0; KP_LAUNDER();
        const float* scale = mode == 0 ? KIN(I_POOLSC) : nullptr;
        bf16_t* base = mode == 2 ? WSP(bf16_t, WS_PART) + (size_t)u.ks * NSR * D : mode == 3 ? WSP(bf16_t, WS_PARTG) + (size_t)u.ks * NSR * 2 * D : WSP(bf16_t, WS_MBUF);
        const int row_off = mode >= 2 ? NPR : 0, ldc = mode == 3 ? 2 * D : D;
#pragma unroll
        for (int bj = 0; bj < 2; ++bj) {
            const int col = u.pn * BM + bj * HALF + wc * 32 + 8 * fq;
            f32x4 s0 = (f32x4){1.f, 1.f, 1.f, 1.f}, s1 = s0;
            if (scale) { s0 = *(const f32x4*)(scale + col); s1 = *(const f32x4*)(scale + col + 4); }
#pragma unroll
            for (int ai = 0; ai < 2; ++ai)
#pragma unroll
                for (int m = 0; m < 4; ++m) {
                    const int row = u.pm * BM + ai * HALF + wr * 64 + m * 16 + fr - row_off;
                    const f32x4 v0 = acc[ai][bj][m][0] * s0, v1 = acc[ai][bj][m][1] * s1;
                    u32x4 w; w.x = cvt_pk_bf16(v0[0], v0[1]); w.y = cvt_pk_bf16(v0[2], v0[3]); w.z = cvt_pk_bf16(v1[0], v1[1]); w.w = cvt_pk_bf16(v1[2], v1[3]);
                    *(u32x4*)(base + (size_t)row * ldc + col) = w;
                }
        }
    }
};
struct EpiGlu {
    static constexpr bool PERM = true;
    kp_t kp0;
    __device__ __forceinline__ void operator()(const f32x4 (&acc)[2][2][4][2], const Unit& u, int wr, int wc, int fr, int fq, LAS unsigned char*) const {
        kp_t kp = kp0; KP_LAUNDER();
        bf16_t* out = WSP(bf16_t, WS_MBUF);
        const int col = u.pn * HALF + wc * 32 + 8 * fq;
#pragma unroll
        for (int ai = 0; ai < 2; ++ai)
#pragma unroll
            for (int m = 0; m < 4; ++m) {
                const int row = u.pm * BM + ai * HALF + wr * 64 + m * 16 + fr;
                float o[8];
#pragma unroll
                for (int n = 0; n < 2; ++n)
#pragma unroll
                    for (int e = 0; e < 4; ++e) o[4 * n + e] = acc[ai][0][m][n][e] * sigmoidf_(acc[ai][1][m][n][e]);
                u32x4 w; w.x = cvt_pk_bf16(o[0], o[1]); w.y = cvt_pk_bf16(o[2], o[3]); w.z = cvt_pk_bf16(o[4], o[5]); w.w = cvt_pk_bf16(o[6], o[7]);
                *(u32x4*)(out + (size_t)row * D + col) = w;
            }
    }
};
struct EpiConv {
    static constexpr bool PERM = true, APERM = true;
    kp_t kp0; int l;
    __device__ __forceinline__ void operator()(const f32x4 (&acc)[2][2][4][2], const Unit& u, int wr, int wc, int fr, int fq, LAS unsigned char* xl) const {
        kp_t kp = kp0; KP_LAUNDER();
        bf16_t* act = WSP(bf16_t, WS_ACT); float* bnd = WSP(float, WS_BND); const float* cw = KIN(I_CONVW) + (size_t)l * 3 * FU; const float* cb = KIN(I_CONVB) + (size_t)l * FU;
        const float* cstate = KIN(I_SCONV) + (size_t)l * 128 * 2 * FU; float* ncs = KOUT() + O_CONVS + (size_t)l * 128 * 2 * FU;
        LAS float* X = (LAS float*)xl;
        const int jl = wc * 32 + 8 * fq;
        const bool sample = u.pm >= (NPR / 256);
#pragma unroll
        for (int ai = 0; ai < 2; ++ai)
#pragma unroll
            for (int bj = 0; bj < 2; ++bj)
#pragma unroll
                for (int n = 0; n < 2; ++n) {
                    const int oc = bj * FH + u.pn * HALF + jl + 4 * n;
                    if (fr == 15) {
                        LAS float* xb = X + ((((ai * 2 + wr) * 2) * 2 + bj) * 128 + jl + 4 * n);
                        *(LAS f32x4*)(xb) = acc[ai][bj][2][n]; *(LAS f32x4*)(xb + 2 * 128) = acc[ai][bj][3][n];
                        if (ai == 1 && wr == 1) { *(f32x4*)(bnd + ((size_t)u.pm * 4 + 2) * FU + oc) = acc[1][bj][2][n]; *(f32x4*)(bnd + ((size_t)u.pm * 4 + 3) * FU + oc) = acc[1][bj][3][n]; }
                    }
                    if (ai == 0 && wr == 0 && fr == 0) { *(f32x4*)(bnd + ((size_t)u.pm * 4 + 0) * FU + oc) = acc[0][bj][0][n]; *(f32x4*)(bnd + ((size_t)u.pm * 4 + 1) * FU + oc) = acc[0][bj][1][n]; }
                }
        asm volatile("s_waitcnt lgkmcnt(0)" ::: "memory"); __builtin_amdgcn_s_barrier(); asm volatile("" ::: "memory");
        u32x2 pk0[2][4];
#pragma unroll
        for (int n = 0; n < 2; ++n) {
            const int j = u.pn * HALF + jl + 4 * n;
            f32x4 w0[2], w1[2], w2[2], bb[2];
#pragma unroll
            for (int bj = 0; bj < 2; ++bj) { const int oc = bj * FH + j; w0[bj] = *(const f32x4*)(cw + oc); w1[bj] = *(const f32x4*)(cw + FU + oc); w2[bj] = *(const f32x4*)(cw + 2 * FU + oc); bb[bj] = *(const f32x4*)(cb + oc); }
#pragma unroll
            for (int ai = 0; ai < 2; ++ai) {
                const int row0 = u.pm * BM + ai * HALF + wr * 64 + 4 * fr;
                f32x4 P3[2], P2[2];
#pragma unroll
                for (int bj = 0; bj < 2; ++bj) {
                    const f32x4 d3 = shr1z(acc[ai][bj][3][n]), d2 = shr1z(acc[ai][bj][2][n]);
                    f32x4 e3 = (f32x4){0.f, 0.f, 0.f, 0.f}, e2 = e3;
                    bool edge;
                    if (!sample) {
                        edge = (fr == 0);
                        if (edge && !(ai == 0 && wr == 0)) {
                            const int pai = wr ? ai : ai - 1, pwr = wr ? 0 : 1;
                            LAS float* xb = X + (((pai * 2 + pwr) * 2) * 2 + bj) * 128 + jl + 4 * n;
                            e2 = *(LAS f32x4*)(xb); e3 = *(LAS f32x4*)(xb + 2 * 128);
                        }
                    } else {
                        edge = ((fr & 1) == 0);
                        if (edge) { const int b = (row0 - NPR) >> 3; const float* sp = cstate + (size_t)b * 2 * FU + bj * FH + j; e2 = *(const f32x4*)(sp); e3 = *(const f32x4*)(sp + FU); }
                    }
                    P3[bj] = edge ? e3 : d3; P2[bj] = edge ? e2 : d2;
                }
#pragma unroll
                for (int m = 0; m < 4; ++m) {
                    const int row = row0 + m;
                    f32x4 cv[2];
#pragma unroll
                    for (int bj = 0; bj < 2; ++bj) {
                        const f32x4 v = acc[ai][bj][m][n];
                        const f32x4 p1 = m == 0 ? P3[bj] : acc[ai][bj][m ? m - 1 : 0][n];
                        const f32x4 p2 = m == 0 ? P2[bj] : (m == 1 ? P3[bj] : acc[ai][bj][m >= 2 ? m - 2 : 0][n]);
                        if (sample && (fr & 1) && m >= 2) { const int b = (row0 - NPR) >> 3; stnt4(ncs + ((size_t)b * 2 + (m - 2)) * FU + bj * FH + j, v); }
                        cv[bj] = bb[bj] + w0[bj] * p2 + w1[bj] * p1 + w2[bj] * v;
                    }
                    const f32x2 g0 = gelu_pk((f32x2){cv[0][0], cv[0][1]}), g1 = gelu_pk((f32x2){cv[0][2], cv[0][3]});
                    u32x2 w; w.x = cvt_pk_bf16(g0.x * cv[1][0], g0.y * cv[1][1]); w.y = cvt_pk_bf16(g1.x * cv[1][2], g1.y * cv[1][3]);
                    if (n == 0) pk0[ai][m] = w;
                    else { u32x4 o; o.x = pk0[ai][m].x; o.y = pk0[ai][m].y; o.z = w.x; o.w = w.y; *(u32x4*)(act + (size_t)row * FH + u.pn * HALF + jl) = o; }
                }
            }
        }
    }
};

template <class E> struct aperm_of { template <class T> static constexpr auto test(int) -> decltype(T::APERM, true) { return T::APERM; } template <class T> static constexpr bool test(...) { return false; } static constexpr bool value = test<E>(0); };
template <class Epi, bool ALIGN_EPI, class Sched>
__device__ __forceinline__ void gemm_phase(LAS unsigned char* lds, LAS unsigned char* xlds, const Gemm g, const Sched& S, const Epi& E, int wave0) {
    asm volatile("" : "+s"(wave0));
    int tid_l = wave0 * 64 + hw_lane(); asm volatile("" : "+v"(tid_l));
    const int tid = tid_l, wid = wave0, lane = tid & 63, wr = wid >> 2, wc = wid & 3, fr = lane & 15, fq = lane >> 4;
    const int K = g.K, nt = K / BK;
    unsigned voffA[2], voffB[2];
#pragma unroll
    for (int i = 0; i < 2; ++i) { int R, C; stage_rc(tid * 16 + i * 8192, R, C); const int Rb = Epi::PERM ? ((R & ~31) + perm32(R & 31)) : R;
        const int Ra = aperm_of<Epi>::value ? (64 * (R >> 6) + 4 * (R & 15) + ((R >> 4) & 3)) : R;
        voffA[i] = (unsigned)(Ra * g.lda + C) * 2u; voffB[i] = (unsigned)(Rb * g.ldb + C) * 2u; }
    const size_t kstep = (size_t)(BK * 2);
    const size_t hstepA = (size_t)HALF * g.lda * 2, tstepA = 2 * hstepA;
    const size_t hstepB = (size_t)HALF * g.ldb * 2, tstepB = 2 * hstepB;
    const size_t pnoffA = (size_t)g.a_pn_off * 2, ksoff = (size_t)g.k_slice * 2;
    const unsigned ldsw = (unsigned)wid * 1024u;
    const int aoff = lds_byte(wr * 64 + fr, fq * 8), boff = lds_byte(wc * 32 + fr, fq * 8);
#define PG8_SA(b, h) (((b) * 2 + (h)) * HTB)
#define PG8_SB(b, h) ((4 + (b) * 2 + (h)) * HTB)
#define PG8_STAGE(bufoff, gbase, voff) do { _Pragma("unroll") for (int _i = 0; _i < 2; ++_i) \
        __builtin_amdgcn_global_load_lds((const unsigned*)((const char*)(gbase) + (voff)[_i]), (LAS unsigned*)(lds + (bufoff) + ldsw + _i * 8192), 16, 0, 0); } while (0)
#define PG8_LDA(dst, b, h) do { _Pragma("unroll") for (int m = 0; m < 4; ++m) _Pragma("unroll") for (int k = 0; k < 2; ++k) dst[m][k] = *(const LAS bf16x8*)(lds + PG8_SA(b, h) + aoff + m * 2048 + k * 1024); } while (0)
#define PG8_LDB(dst, b, h) do { _Pragma("unroll") for (int n = 0; n < 2; ++n) _Pragma("unroll") for (int k = 0; k < 2; ++k) dst[n][k] = *(const LAS bf16x8*)(lds + PG8_SB(b, h) + boff + n * 2048 + k * 1024); } while (0)
#define PG8_MMA(ai, bj, At, Bt) do { __builtin_amdgcn_s_setprio(1); _Pragma("unroll") for (int m = 0; m < 4; ++m) _Pragma("unroll") for (int n = 0; n < 2; ++n) _Pragma("unroll") for (int k = 0; k < 2; ++k) \
        acc[ai][bj][m][n] = __builtin_amdgcn_mfma_f32_16x16x32_bf16(Bt[n][k], At[m][k], acc[ai][bj][m][n], 0, 0, 0); __builtin_amdgcn_s_setprio(0); } while (0)
#define PG8_WAIT_V(n) asm volatile("s_waitcnt vmcnt(" #n ")" ::: "memory")
#define PG8_WAIT_L(n) asm volatile("s_waitcnt lgkmcnt(" #n ")" ::: "memory")
#define PG8_BAR __builtin_amdgcn_s_barrier()
#define PG8_SCHED __builtin_amdgcn_sched_barrier(0)
    Unit cur, nxt; int ui = 0;
    if (!S.next(0, cur)) return;
    f32x4 acc[2][2][4][2];
#pragma unroll
    for (int a = 0; a < 2; ++a)
#pragma unroll
        for (int b = 0; b < 2; ++b)
#pragma unroll
            for (int m = 0; m < 4; ++m)
#pragma unroll
                for (int n = 0; n < 2; ++n) acc[a][b][m][n] = (f32x4){0.f, 0.f, 0.f, 0.f};
    bf16x8 At[4][2], B0[2][2], B1[2][2];
    const char* cA = (const char*)g.A + (size_t)cur.pm * tstepA + (size_t)cur.pn * pnoffA + (size_t)cur.ks * ksoff; const char* cB = (const char*)g.Bt + (size_t)cur.pn * tstepB + (size_t)cur.ks * ksoff;
    PG8_STAGE(PG8_SB(0, 0), cB, voffB); PG8_STAGE(PG8_SB(0, 1), cB + hstepB, voffB); PG8_STAGE(PG8_SA(0, 0), cA, voffA); PG8_STAGE(PG8_SA(0, 1), cA + hstepA, voffA);
    if (wr == 1) PG8_BAR;
    PG8_WAIT_V(2); PG8_BAR;
    PG8_STAGE(PG8_SB(1, 0), cB + kstep, voffB); PG8_STAGE(PG8_SA(1, 0), cA + kstep, voffA); PG8_STAGE(PG8_SB(1, 1), cB + hstepB + kstep, voffB);
    PG8_WAIT_V(6); PG8_BAR;
    for (;;) {
        const bool has_next = S.next(ui + 1, nxt);
        const char* nA = has_next ? (const char*)g.A + (size_t)nxt.pm * tstepA + (size_t)nxt.pn * pnoffA + (size_t)nxt.ks * ksoff : cA; const char* nB = has_next ? (const char*)g.Bt + (size_t)nxt.pn * tstepB + (size_t)nxt.ks * ksoff : cB;
        for (int t = 0; t < nt; t += 2) {
            const bool last = (t == nt - 2);
            const char* a1 = cA + (size_t)(t + 1) * kstep;
            const char* a2 = last ? nA : cA + (size_t)(t + 2) * kstep; const char* b2 = last ? nB : cB + (size_t)(t + 2) * kstep;
            const char* a3 = a2 + kstep; const char* b3 = b2 + kstep;
            PG8_LDB(B0, 0, 0); PG8_LDB(B1, 0, 1); PG8_SCHED; PG8_LDA(At, 0, 0); PG8_STAGE(PG8_SA(1, 1), a1 + hstepA, voffA);
            PG8_WAIT_V(8); PG8_WAIT_L(0); PG8_BAR; PG8_MMA(0, 0, At, B0); PG8_MMA(0, 1, At, B1); PG8_BAR; PG8_SCHED;
            PG8_LDA(At, 0, 1); PG8_STAGE(PG8_SB(0, 0), b2, voffB); PG8_STAGE(PG8_SB(0, 1), b2 + hstepB, voffB); PG8_STAGE(PG8_SA(0, 0), a2, voffA);
            PG8_WAIT_V(8); PG8_WAIT_L(0); PG8_BAR; PG8_MMA(1, 0, At, B0); PG8_MMA(1, 1, At, B1); PG8_BAR; PG8_SCHED;
            PG8_LDB(B0, 1, 0); PG8_LDB(B1, 1, 1); PG8_SCHED; PG8_LDA(At, 1, 0); PG8_STAGE(PG8_SA(0, 1), a2 + hstepA, voffA);
            PG8_WAIT_V(8); PG8_WAIT_L(0); PG8_BAR; PG8_MMA(0, 0, At, B0); PG8_MMA(0, 1, At, B1); PG8_BAR; PG8_SCHED;
            PG8_LDA(At, 1, 1); PG8_STAGE(PG8_SB(1, 0), b3, voffB); PG8_STAGE(PG8_SB(1, 1), b3 + hstepB, voffB); PG8_STAGE(PG8_SA(1, 0), a3, voffA);
            PG8_WAIT_V(8); PG8_WAIT_L(0); PG8_BAR; PG8_MMA(1, 0, At, B0); PG8_MMA(1, 1, At, B1); PG8_BAR; PG8_SCHED;
        }
        if constexpr (ALIGN_EPI) { if (wr == 0) PG8_BAR; }
        E(acc, cur, wr, wc, fr, fq, xlds);
        if (!has_next) break;
#pragma unroll
        for (int a = 0; a < 2; ++a)
#pragma unroll
            for (int b = 0; b < 2; ++b)
#pragma unroll
                for (int m = 0; m < 4; ++m)
#pragma unroll
                    for (int n = 0; n < 2; ++n) acc[a][b][m][n] = (f32x4){0.f, 0.f, 0.f, 0.f};
        cur = nxt; cA = nA; cB = nB; ++ui;
        if constexpr (ALIGN_EPI) { if (wr == 1) PG8_BAR; }
    }
    PG8_WAIT_V(0);
    if constexpr (!ALIGN_EPI) { if (wr == 0) PG8_BAR; }
    PG8_BAR;
#undef PG8_SA
#undef PG8_SB
#undef PG8_STAGE
#undef PG8_LDA
#undef PG8_LDB
#undef PG8_MMA
#undef PG8_WAIT_V
#undef PG8_WAIT_L
#undef PG8_BAR
#undef PG8_SCHED
}
}

#define XB_TMO      128
#define XB_XCNT(j)  (256  + 64 * (j))
#define XB_XSUB(j)  (1280 + 64 * (j))
#define XB_XGEN(j)  (2304 + 64 * (j))
#define XB_TOP      3328
#define XB_TOPGEN   3392
#define XCD_BAR_WORDS 3456
#define XB_SPIN_CAP (1u << 22)
__device__ __forceinline__ unsigned xb_ld(unsigned* p)              { return __hip_atomic_load(p, __ATOMIC_RELAXED, __HIP_MEMORY_SCOPE_AGENT); }
__device__ __forceinline__ unsigned xb_add(unsigned* p, unsigned v) { return __hip_atomic_fetch_add(p, v, __ATOMIC_RELAXED, __HIP_MEMORY_SCOPE_AGENT); }
__device__ __forceinline__ unsigned xb_xcc_id() { return (unsigned)__builtin_amdgcn_s_getreg((3 << 11) | 20) & 0xFu; }
#define XB_SPIN(cond, bar) do { unsigned _sp = 0; while (cond) { __builtin_amdgcn_s_sleep(1); \
    if ((++_sp & 255u) == 0u) { if (xb_ld(&(bar)[XB_TMO])) break; if (_sp > XB_SPIN_CAP) { atomicAdd(&(bar)[XB_TMO], 1u); break; } } } } while (0)
struct XcdBarrier { unsigned* bar; unsigned x; volatile LAS unsigned* st; };
__device__ __forceinline__ XcdBarrier xcd_barrier_post(unsigned* bar, volatile LAS unsigned* st) {
    XcdBarrier b; b.bar = bar; b.x = xb_xcc_id(); b.st = st;
    if (threadIdx.x == 0) (void)xb_add(&bar[XB_XCNT(b.x)], 1u);
    return b;
}
__device__ __forceinline__ void xcd_barrier_complete(unsigned* bar, unsigned x, unsigned& nloc, unsigned& nx) {
    const unsigned G = gridDim.x * gridDim.y * gridDim.z;
    unsigned sum, cnt, mine, sp = 0u;
    for (;;) {
        sum = 0u; cnt = 0u; mine = 0u;
#pragma unroll
        for (unsigned j = 0; j < 16; ++j) { const unsigned c = xb_ld(&bar[XB_XCNT(j)]); sum += c; cnt += (c > 0u) ? 1u : 0u; }
        mine = xb_ld(&bar[XB_XCNT(x)]);
        if (sum == G) break;
        __builtin_amdgcn_s_sleep(1);
        if ((++sp & 255u) == 0u) { if (xb_ld(&bar[XB_TMO])) break; if (sp > XB_SPIN_CAP) { atomicAdd(&bar[XB_TMO], 1u); break; } }
    }
    nloc = mine > 0u ? mine : 1u; nx = cnt > 0u ? cnt : 1u;
}
__device__ __forceinline__ void xcd_barrier_kp(kp_t kp, volatile LAS unsigned* st) {
    XcdBarrier b; b.st = st;
    asm volatile("s_waitcnt vmcnt(0)" ::: "memory");
    __syncthreads();
    if (threadIdx.x == 0) {
        KP_LAUNDER();
        unsigned* bar = (unsigned*)(KWS() + WS_CTL) + CW_BAR; unsigned bx_ = xb_xcc_id();
        asm volatile("" : "+s"(bar), "+s"(bx_));
        __builtin_amdgcn_s_waitcnt(0);
        unsigned nloc = b.st[0], nx = b.st[1];
        if (nloc == 0u) { xcd_barrier_complete(bar, bx_, nloc, nx); b.st[0] = nloc; b.st[1] = nx; }
        const unsigned old = xb_add(&bar[XB_XSUB(bx_)], 1u);
        const unsigned gen = old / nloc;
        if (old + 1u == (gen + 1u) * nloc) {
            __builtin_amdgcn_fence(__ATOMIC_RELEASE, "agent");
            asm volatile("s_waitcnt vmcnt(0)" ::: "memory");
            const unsigned og = xb_add(&bar[XB_TOP], 1u);
            const unsigned tg = og / nx;
            if (og + 1u == (tg + 1u) * nx) xb_add(&bar[XB_TOPGEN], 1u);
            else XB_SPIN(xb_ld(&bar[XB_TOPGEN]) == tg, bar);
            __builtin_amdgcn_fence(__ATOMIC_ACQUIRE, "agent");
            xb_add(&bar[XB_XGEN(bx_)], 1u);
            asm volatile("s_waitcnt vmcnt(0)" ::: "memory");
        } else {
            XB_SPIN(xb_ld(&bar[XB_XGEN(bx_)]) == gen, bar);
            __builtin_amdgcn_fence(__ATOMIC_ACQUIRE, "agent");
            asm volatile("s_waitcnt vmcnt(0)" ::: "memory");
        }
    }
    __syncthreads();
}

struct Args { const float* in[30]; float* out; unsigned char* ws; };

__device__ __forceinline__ void transpose_item(const float* W, int ldw, int k0, int n0, bf16_t* WT, int ldt, int drow0, LAS float* scr, int lane) {
    float tv[32];
#pragma unroll
    for (int i = 0; i < 32; ++i) { const int kk = 2 * i + (lane >> 5); tv[i] = __builtin_nontemporal_load(&W[(size_t)(k0 + kk) * ldw + n0 + (lane & 31)]); }
#pragma unroll
    for (int i = 0; i < 32; ++i) { const int kk = 2 * i + (lane >> 5); scr[kk * 33 + (lane & 31)] = tv[i]; }
    asm volatile("s_waitcnt lgkmcnt(0)" ::: "memory");
    const int c = lane & 7;
#pragma unroll
    for (int j = 0; j < 4; ++j) { const int n = (lane >> 3) + 8 * j; const LAS float* s = scr + (8 * c) * 33 + n;
        u32x4 o; o.x = cvt_pk_bf16(s[0 * 33], s[1 * 33]); o.y = cvt_pk_bf16(s[2 * 33], s[3 * 33]); o.z = cvt_pk_bf16(s[4 * 33], s[5 * 33]); o.w = cvt_pk_bf16(s[6 * 33], s[7 * 33]);
        *(u32x4*)(WT + (size_t)(drow0 + n) * ldt + k0 + 8 * c) = o; }
    asm volatile("s_waitcnt lgkmcnt(0)" ::: "memory");
}
__device__ __forceinline__ void sincos_d(double x, double& s, double& c) {
    const double k = rint(x * 0.63661977236758134308);
    double r = fma(-k, 1.57079632679489655800e+00, x); r = fma(-k, 6.12323399573676603587e-17, r);
    const double r2 = r * r;
    double sp = -7.6471637318198164759e-13; sp = fma(sp, r2, 1.6059043836821614599e-10); sp = fma(sp, r2, -2.5052108385441718775e-08); sp = fma(sp, r2, 2.7557319223985890653e-06);
    sp = fma(sp, r2, -1.9841269841269841270e-04); sp = fma(sp, r2, 8.3333333333333333333e-03); sp = fma(sp, r2, -1.6666666666666666667e-01);
    const double sr = fma(sp * r2, r, r);
    double cp = 4.7794773323873852974e-14; cp = fma(cp, r2, -1.1470745597729724714e-11); cp = fma(cp, r2, 2.0876756987868098979e-09); cp = fma(cp, r2, -2.7557319223985890653e-07);
    cp = fma(cp, r2, 2.4801587301587301587e-05); cp = fma(cp, r2, -1.3888888888888888889e-03); cp = fma(cp, r2, 4.1666666666666666667e-02); cp = fma(cp, r2, -0.5);
    const double cr = fma(cp, r2, 1.0);
    const int q = ((int)k) & 3;
    s = (q == 0) ? sr : (q == 1) ? cr : (q == 2) ? -sr : -cr;
    c = (q == 0) ? cr : (q == 1) ? -sr : (q == 2) ? -cr : sr;
}

template <int W, bool SAMPLE>
__device__ __forceinline__ void pool_item(int it, int c4, const float* xp, const float* xs, const float* spool, const float* rstd0, const float* mod0, const float* g0,
                                          bf16_t* pooled, float* o_poolp, float* o_pools) {
    const f32x4 gv = *(const f32x4*)(g0 + c4);
    constexpr float invW = 1.0f / W;
    if constexpr (!SAMPLE) {
        const int r0 = it * 32, b = r0 >> 11, t0 = r0 & (SEQ - 1);
        const f32x4 shv = *(const f32x4*)(mod0 + (size_t)b * 6144 + c4), scv = *(const f32x4*)(mod0 + (size_t)b * 6144 + 1024 + c4);
        const f32x4 gs = gv * (scv + 1.0f);
        f32x4 ring[W];
#pragma unroll
        for (int i = 0; i < W - 1; ++i) {
            const int t = t0 - (W - 1) + i; const int row = t >= 0 ? r0 - (W - 1) + i : r0;
            ring[i] = *(const f32x4*)(xp + (size_t)row * D + c4);
        }
        asm volatile("" ::: "memory");
#pragma unroll
        for (int i = 0; i < W - 1; ++i) {
            const int t = t0 - (W - 1) + i; const int row = t >= 0 ? r0 - (W - 1) + i : r0;
            const float keep = t >= 0 ? 1.0f : 0.0f;
            ring[i] = (ring[i] * rstd0[row] * gs + shv) * keep;
        }
        ring[W - 1] = (f32x4){0.f, 0.f, 0.f, 0.f};
        f32x4 rs = ring[0];
#pragma unroll
        for (int k = 1; k < W - 1; ++k) rs += ring[k];
        constexpr int QB = (W >= 16) ? 8 : 16;
#pragma unroll
        for (int q8 = 0; q8 < 32; q8 += QB) {
            f32x4 xv[QB];
#pragma unroll
            for (int i = 0; i < QB; ++i) xv[i] = *(const f32x4*)(xp + (size_t)(r0 + q8 + i) * D + c4);
            asm volatile("" ::: "memory");
#pragma unroll
            for (int i = 0; i < QB; ++i) {
                const int q = q8 + i, row = r0 + q, t = t0 + q;
                const f32x4 h = xv[i] * rstd0[row] * gs + shv;
                f32x4 s;
                if constexpr (W >= 8) { rs = rs - ring[(q + W - 1) % W] + h; ring[(q + W - 1) % W] = h; s = rs; }
                else {
                    ring[(q + W - 1) % W] = h;
                    s = ring[0];
#pragma unroll
                    for (int k = 1; k < W; ++k) s += ring[k];
                }
                const float ic = (t + 1 >= W) ? invW : 1.0f / (float)(t + 1);
                const f32x4 o = s * ic - h;
                u32x2 w; w.x = cvt_pk_bf16(o[0], o[1]); w.y = cvt_pk_bf16(o[2], o[3]);
                *(u32x2*)(pooled + (size_t)row * D + c4) = w;
                if (t >= SEQ - 15) stnt4(o_poolp + ((size_t)b * 15 + (t - (SEQ - 15))) * D + c4, h);
            }
            asm volatile("" ::: "memory");
        }
    } else {
        {
            const int b = it, cb = 8 + b;
            const f32x4 shv = *(const f32x4*)(mod0 + (size_t)cb * 6144 + c4), scv = *(const f32x4*)(mod0 + (size_t)cb * 6144 + 1024 + c4);
            const f32x4 gs = gv * (scv + 1.0f);
            const float* sp = spool + (size_t)b * 15 * D + c4;
            f32x4 ring[W];
#pragma unroll
            for (int i = 0; i < W - 1; ++i) ring[i] = *(const f32x4*)(sp + (size_t)(15 - (W - 1) + i) * D);
            asm volatile("" ::: "memory");
#pragma unroll
            for (int i = 0; i < 7; ++i) *(f32x4*)(o_pools + ((size_t)b * 15 + i) * D + c4) = *(const f32x4*)(sp + (size_t)(8 + i) * D);
            asm volatile("" ::: "memory");
#pragma unroll
            for (int q = 0; q < 8; ++q) {
                const int row = NPR + b * 8 + q;
                const f32x4 h = *(const f32x4*)(xs + (size_t)(b * 8 + q) * D + c4) * rstd0[row] * gs + shv;
                ring[(q + W - 1) % W] = h;
                f32x4 s = ring[0];
#pragma unroll
                for (int i = 1; i < W; ++i) s += ring[i];
                const f32x4 o = s * invW - h;
                u32x2 w; w.x = cvt_pk_bf16(o[0], o[1]); w.y = cvt_pk_bf16(o[2], o[3]);
                *(u32x2*)(pooled + (size_t)row * D + c4) = w;
                stnt4(o_pools + ((size_t)b * 15 + 7 + q) * D + c4, h);
            }
        }
    }
}

__device__ __forceinline__ f32x4 bf4(u32x2 w) { return (f32x4){__builtin_bit_cast(float, w.x << 16), __builtin_bit_cast(float, w.x & 0xffff0000u), __builtin_bit_cast(float, w.y << 16), __builtin_bit_cast(float, w.y & 0xffff0000u)}; }
template <int PM, bool YIN_F32, bool YOUT_F32>
__device__ __forceinline__ void row_phase(int gw, int NGW, int lane, const float* yin_p, const float* yin_s, float* yout, bf16_t* yb, const bf16_t* mb, const bf16_t* part,
                                          const float* modl, int gate_off, const float* post_g,
                                          const float* nmod, int nsh_off, int nsc_off, const float* ng, bf16_t* aout) {
    constexpr int RQ = 4;
    for (int row0 = gw; row0 < MROWS; row0 += RQ * NGW) {
        f32x4 y[RQ][4], m[RQ][4]; int rows[RQ]; bool ok[RQ];
#pragma unroll
        for (int q = 0; q < RQ; ++q) {
            const int row = row0 + q * NGW; rows[q] = row; ok[q] = row < MROWS;
            if (!ok[q]) continue;
            if constexpr (YIN_F32) {
                const float* yr = row < NPR ? yin_p + (size_t)row * D : yin_s + (size_t)(row - NPR) * D;
#pragma unroll
                for (int j = 0; j < 4; ++j) y[q][j] = ldnt4(yr + 4 * lane + 256 * j);
            } else {
#pragma unroll
                for (int j = 0; j < 4; ++j) y[q][j] = bf4(ldnt2u(yb + (size_t)row * D + 4 * lane + 256 * j));
            }
            if (PM == 1 && row >= NPR) {
#pragma unroll
                for (int j = 0; j < 4; ++j) m[q][j] = (f32x4){0.f, 0.f, 0.f, 0.f};
#pragma unroll 1
                for (int ks = 0; ks < NKS; ++ks) {
                    const bf16_t* pr = part + ((size_t)ks * NSR + (row - NPR)) * D;
#pragma unroll
                    for (int j = 0; j < 4; ++j) m[q][j] += bf4(ldnt2u(pr + 4 * lane + 256 * j));
                }
            } else if (PM == 2 && row >= NPR) {
#pragma unroll
                for (int j = 0; j < 4; ++j) {
                    const int c = 4 * lane + 256 * j, pc = 256 * (c >> 7) + (c & 127);
                    f32x4 av = (f32x4){0.f, 0.f, 0.f, 0.f}, bv = av;
#pragma unroll
                    for (int ks = 0; ks < NKG; ++ks) { const bf16_t* pr = part + ((size_t)ks * NSR + (row - NPR)) * 2 * D + pc; av += bf4(*(const u32x2*)pr); bv += bf4(*(const u32x2*)(pr + 128)); }
                    m[q][j] = (f32x4){av[0] * sigmoidf_(bv[0]), av[1] * sigmoidf_(bv[1]), av[2] * sigmoidf_(bv[2]), av[3] * sigmoidf_(bv[3])};
                }
            } else {
                const bf16_t* mr = mb + (size_t)row * D;
#pragma unroll
                for (int j = 0; j < 4; ++j) m[q][j] = bf4(ldnt2u(mr + 4 * lane + 256 * j));
            }
        }
#pragma unroll
        for (int q = 0; q < RQ; ++q) {
            if (!ok[q]) continue;
            const int row = rows[q];
            const int cb = row < NPR ? (row >> 11) : 8 + ((row - NPR) >> 3);
            float ss = 0.f;
#pragma unroll
            for (int j = 0; j < 4; ++j) ss += (m[q][j][0] * m[q][j][0] + m[q][j][1] * m[q][j][1]) + (m[q][j][2] * m[q][j][2] + m[q][j][3] * m[q][j][3]);
            const float rm = 1.0f / sqrtf(wave_sum(ss) * (1.0f / D) + EPS);
            float s2 = 0.f;
#pragma unroll
            for (int j = 0; j < 4; ++j) { const int c = 4 * lane + 256 * j;
                const f32x4 gt = *(const f32x4*)(modl + (size_t)cb * 6144 + gate_off + c), pg = *(const f32x4*)(post_g + c);
                y[q][j] = y[q][j] + gt * (m[q][j] * rm * pg);
                if constexpr (YOUT_F32) stnt4(yout + (size_t)row * D + c, y[q][j]);
                else { u32x2 wy; wy.x = cvt_pk_bf16(y[q][j][0], y[q][j][1]); wy.y = cvt_pk_bf16(y[q][j][2], y[q][j][3]); *(u32x2*)(yb + (size_t)row * D + c) = wy; }
                s2 += (y[q][j][0] * y[q][j][0] + y[q][j][1] * y[q][j][1]) + (y[q][j][2] * y[q][j][2] + y[q][j][3] * y[q][j][3]); }
            if (aout) {
                const float ry = 1.0f / sqrtf(wave_sum(s2) * (1.0f / D) + EPS);
#pragma unroll
                for (int j = 0; j < 4; ++j) { const int c = 4 * lane + 256 * j;
                    const f32x4 g = *(const f32x4*)(ng + c), sc = *(const f32x4*)(nmod + (size_t)cb * 6144 + nsc_off + c), sh = *(const f32x4*)(nmod + (size_t)cb * 6144 + nsh_off + c);
                    const f32x4 f = y[q][j] * ry * g * (sc + 1.0f) + sh;
                    u32x2 w; w.x = cvt_pk_bf16(f[0], f[1]); w.y = cvt_pk_bf16(f[2], f[3]);
                    *(u32x2*)(aout + (size_t)row * D + c) = w; }
            }
        }
    }
}

constexpr int S5_SEG = 512, S5_NSEG = SEQ / S5_SEG;
constexpr int S5_LP = 68;
template <int MODE>
__device__ __forceinline__ void s5_unit(int unit, int lane, LAS float* T, const bf16_t* H, bf16_t* GY, const bf16_t* BBT, const bf16_t* CMT, const float* LBR, const float* LBI,
                                        const float* x0re, const float* x0im, float* ore, float* oim, float* carry) {
    constexpr bool SAMPLE = (MODE == 1);
    int g, row0, ntiles, b0, seg = 0;
    if constexpr (MODE == 0) { seg = unit & 3; g = (unit >> 2) & 63; b0 = unit >> 8; row0 = b0 * SEQ + seg * S5_SEG; ntiles = S5_SEG / 32; }
    else if constexpr (MODE == 2) { seg = unit % 3; const int bg = unit / 3; g = bg & 63; b0 = bg >> 6; row0 = b0 * SEQ + seg * S5_SEG; ntiles = S5_SEG / 32; }
    else { g = unit & 63; const int ch = unit >> 6; row0 = NPR + ch * 32; ntiles = 1; b0 = ch * 4; }
    const int p = lane;
    LAS unsigned* TP = (LAS unsigned*)T;
    const float lbr = LBR[g * 64 + p], lbi = LBI[g * 64 + p];
    bf16x8 bb[4], cm[5];
#pragma unroll
    for (int nt = 0; nt < 4; ++nt) bb[nt] = *(const bf16x8*)(BBT + ((size_t)(g * 128 + 32 * nt + (lane & 31)) * 16 + 8 * (lane >> 5)));
    if constexpr (MODE != 2) {
#pragma unroll
        for (int ks = 0; ks < 5; ++ks) cm[ks] = *(const bf16x8*)(CMT + ((size_t)(g * 16 + (lane & 15)) * 160 + 32 * ks + 8 * (lane >> 4)));
    }
    float sr = 0.f, si = 0.f;
    if constexpr (MODE == 0) {
        if (seg > 0) {
            float pr = lbr, pi = lbi;
#pragma unroll
            for (int i = 0; i < 9; ++i) { const float nr = pr * pr - pi * pi, ni = 2.f * pr * pi; pr = nr; pi = ni; }
            const float* cp = carry + ((size_t)(b0 * 64 + g) * 3) * 128 + p;
            for (int j = 0; j < seg; ++j) { const float er = cp[j * 128], ei = cp[j * 128 + 64]; const float nr = pr * sr - pi * si + er, ni = pr * si + pi * sr + ei; sr = nr; si = ni; }
        }
    }
    float x0r[4] = {0.f, 0.f, 0.f, 0.f}, x0i[4] = {0.f, 0.f, 0.f, 0.f};
    if constexpr (SAMPLE) {
#pragma unroll
        for (int k = 0; k < 4; ++k) { const size_t xi = ((size_t)(b0 + k) * 64 + g) * 64 + p; x0r[k] = x0re[xi]; x0i[k] = x0im[xi]; }
    }
    const bf16x8 zero8 = (bf16x8){0, 0, 0, 0, 0, 0, 0, 0};
    const bf16_t* hb = H + (size_t)row0 * D + g * 16;
    bf16x8 ua = *(const bf16x8*)(hb + (size_t)(lane & 31) * D + 8 * (lane >> 5));
    bf16x8 ud0 = zero8, ud1 = zero8;
    if constexpr (MODE != 2) { if (lane < 32) { ud0 = *(const bf16x8*)(hb + (size_t)(lane & 15) * D + 8 * (lane >> 4)); ud1 = *(const bf16x8*)(hb + (size_t)(16 + (lane & 15)) * D + 8 * (lane >> 4)); } }
#pragma unroll 1
    for (int tile = 0; tile < ntiles; ++tile) {
        const bf16x8 ca = ua, cd0 = ud0, cd1 = ud1;
        if (tile + 1 < ntiles) {
            const bf16_t* hn = hb + (size_t)(tile + 1) * 32 * D;
            ua = *(const bf16x8*)(hn + (size_t)(lane & 31) * D + 8 * (lane >> 5));
            if constexpr (MODE != 2) { if (lane < 32) { ud0 = *(const bf16x8*)(hn + (size_t)(lane & 15) * D + 8 * (lane >> 4)); ud1 = *(const bf16x8*)(hn + (size_t)(16 + (lane & 15)) * D + 8 * (lane >> 4)); } }
        }
        f32x16 z0, z1, z2, z3;
#pragma unroll
        for (int i = 0; i < 16; ++i) { z0[i] = 0.f; z1[i] = 0.f; z2[i] = 0.f; z3[i] = 0.f; }
        z0 = __builtin_amdgcn_mfma_f32_32x32x16_bf16(ca, bb[0], z0, 0, 0, 0);
        z1 = __builtin_amdgcn_mfma_f32_32x32x16_bf16(ca, bb[1], z1, 0, 0, 0);
        z2 = __builtin_amdgcn_mfma_f32_32x32x16_bf16(ca, bb[2], z2, 0, 0, 0);
        z3 = __builtin_amdgcn_mfma_f32_32x32x16_bf16(ca, bb[3], z3, 0, 0, 0);
        asm volatile("s_nop 15\n\ts_nop 15\n\ts_nop 15\n\ts_nop 15\n\ts_nop 15" : "+v"(z0), "+v"(z1), "+v"(z2), "+v"(z3));
#pragma unroll
        for (int r = 0; r < 16; ++r) {
            float x0 = z0[r], x1 = z1[r], x2 = z2[r], x3 = z3[r];
            asm volatile("s_nop 1\n\tv_permlane32_swap_b32 %0, %1" : "+v"(x0), "+v"(x1));
            asm volatile("s_nop 1\n\tv_permlane32_swap_b32 %0, %1" : "+v"(x2), "+v"(x3));
            z0[r] = x0; z1[r] = x1; z2[r] = x2; z3[r] = x3;
        }
#pragma unroll
        for (int j = 0; j < 4; ++j) {
#pragma unroll
            for (int hh = 0; hh < 2; ++hh)
#pragma unroll
                for (int i = 0; i < 4; ++i) {
                    const int r = 4 * j + i, t = 8 * j + 4 * hh + i;
                    if constexpr (SAMPLE) { if ((t & 7) == 0) { sr = x0r[t >> 3]; si = x0i[t >> 3]; } }
                    const float br = hh ? z1[r] : z0[r], bi = hh ? z3[r] : z2[r];
                    const float nr = __builtin_fmaf(lbr, sr, __builtin_fmaf(-lbi, si, br)), ni = __builtin_fmaf(lbr, si, __builtin_fmaf(lbi, sr, bi));
                    sr = nr; si = ni;
                    if (hh) { z1[r] = nr; z3[r] = ni; } else { z0[r] = nr; z2[r] = ni; }
                    if constexpr (SAMPLE) { if ((t & 7) == 7) { const size_t xi = ((size_t)(b0 + (t >> 3)) * 64 + g) * 64 + p; ore[xi] = sr; oim[xi] = si; } }
                }
        }
        if constexpr (MODE != 2) {
#pragma unroll
            for (int r = 0; r < 16; ++r) {
                const int t0 = (r & 3) + 8 * (r >> 2);
                TP[t0 * S5_LP + p] = cvt_pk_bf16(z0[r], z2[r]);
                TP[(t0 + 4) * S5_LP + p] = cvt_pk_bf16(z1[r], z3[r]);
            }
        }
        asm volatile("s_waitcnt lgkmcnt(0)" ::: "memory");
        if constexpr (MODE != 2) {
#pragma unroll
        for (int rt = 0; rt < 2; ++rt) {
            f32x4 y = (f32x4){0.f, 0.f, 0.f, 0.f};
#pragma unroll
            for (int ks = 0; ks < 4; ++ks) {
                const u32x4 pk = *(const LAS u32x4*)(TP + (16 * rt + (lane & 15)) * S5_LP + 16 * ks + 4 * (lane >> 4));
                y = __builtin_amdgcn_mfma_f32_16x16x32_bf16(__builtin_bit_cast(bf16x8, pk), cm[ks], y, 0, 0, 0);
            }
            y = __builtin_amdgcn_mfma_f32_16x16x32_bf16(rt ? cd1 : cd0, cm[4], y, 0, 0, 0);
            const f32x2 ga = gelu_pk((f32x2){y[0], y[1]}), gb = gelu_pk((f32x2){y[2], y[3]});
            const unsigned pa = cvt_pk_bf16(ga.x, ga.y), pb = cvt_pk_bf16(gb.x, gb.y);
            {
                const size_t o0 = (size_t)(row0 + tile * 32 + 16 * rt + 4 * (lane >> 4)) * D + g * 16 + (lane & 15);
                GY[o0] = (bf16_t)(pa & 0xffffu); GY[o0 + D] = (bf16_t)(pa >> 16); GY[o0 + 2 * D] = (bf16_t)(pb & 0xffffu); GY[o0 + 3 * D] = (bf16_t)(pb >> 16);
            }
        }
        asm volatile("s_waitcnt lgkmcnt(0)" ::: "memory");
        }
    }
    if constexpr (MODE == 0) { if (seg == S5_NSEG - 1) { const size_t xi = ((size_t)b0 * 64 + g) * 64 + p; ore[xi] = sr; oim[xi] = si; } }
    if constexpr (MODE == 2) { float* cp = carry + ((size_t)(b0 * 64 + g) * 3 + seg) * 128 + p; cp[0] = sr; cp[64] = si; }
}

#define PH_SC() int G = gridDim.x, bx = blockIdx.x; asm volatile("" : "+s"(G), "+s"(bx)); (void)G; (void)bx
#define PH_IDS() PH_SC(); int tid = wave0 * 64 + hw_lane(); asm volatile("" : "+v"(tid)); const int vcu = (G % 8 == 0) ? (bx % 8) * (G / 8) + bx / 8 : bx; const int NGW = G * 8; const int lane = tid & 63, wave = __builtin_amdgcn_readfirstlane(tid >> 6), gw = vcu * 8 + wave; (void)lane; (void)gw; (void)NGW
#ifndef REP_BAR
#define REP_BAR 1
#endif
#define GRID_BAR() do { for (int rb_ = 0; rb_ < REP_BAR; ++rb_) xcd_barrier_kp(kp, (volatile LAS unsigned*)(lds + MISC_OFF) + 8); } while (0)

template <int l>
__device__ __forceinline__ void rowa_phase(kp_t kp, LAS unsigned char* lds, const int wave0) {
        {
            PH_IDS();
            float* Y = KOUT() + O_Y; const float* modl = WSP(float, WS_MOD) + (size_t)l * NCB * 6144;
            row_phase<(l == 0 ? 0 : 2), (l == 0), false>(gw, NGW, lane, KIN(I_XP), KIN(I_XS), Y, WSP(bf16_t, WS_YB), WSP(bf16_t, WS_MBUF), WSP(bf16_t, WS_PARTG), modl, 2048, KIN(I_MPOSTG) + l * D,
                      modl, 3072, 4096, KIN(I_FPREG) + l * D, WSP(bf16_t, WS_ABUF));
        }
}

template <int l>
__device__ __forceinline__ void down_phase(kp_t kp, LAS unsigned char* lds, const int wave0) {
        {
            PH_IDS();
            const float* cw = KIN(I_CONVW) + (size_t)l * 3 * FU; const float* cbv = KIN(I_CONVB) + (size_t)l * FU;
            const float* BND = WSP(float, WS_BND); bf16_t* ACT = WSP(bf16_t, WS_ACT);
            pg8::StaticOrder S0; S0.init(NPR, D, G, bx); pg8::Unit u0;
            if (S0.next(0, u0) && (u0.pm & 7) != 0) {
                const int pm = u0.pm;
                for (int j = tid; j < FH; j += 512) {
                    float e[2][4];
#pragma unroll
                    for (int h = 0; h < 2; ++h) { const int oc = h * FH + j;
                        e[h][0] = BND[((size_t)(pm - 1) * 4 + 2) * FU + oc]; e[h][1] = BND[((size_t)(pm - 1) * 4 + 3) * FU + oc];
                        e[h][2] = BND[((size_t)pm * 4 + 0) * FU + oc]; e[h][3] = BND[((size_t)pm * 4 + 1) * FU + oc]; }
#pragma unroll
                    for (int r = 0; r < 2; ++r) {
                        float cv[2];
#pragma unroll
                        for (int h = 0; h < 2; ++h) { const int oc = h * FH + j; cv[h] = cbv[oc] + cw[oc] * e[h][r] + cw[FU + oc] * e[h][r + 1] + cw[2 * FU + oc] * e[h][r + 2]; }
                        ACT[(size_t)(pm * 256 + r) * FH + j] = (bf16_t)(cvt_pk_bf16(gelu1(cv[0]) * cv[1], 0.f) & 0xffffu);
                    }
                }
            }
            float* ocp = KOUT() + O_CONVP + (size_t)l * 8 * 2 * FU;
            for (int i = bx * 512 + tid; i < 8 * 2 * FU; i += G * 512) {
                const int b = i / (2 * FU), sidx = (i / FU) & 1, n = i % FU;
                ocp[i] = BND[((size_t)(8 * b + 7) * 4 + 2 + sidx) * FU + n];
            }
            asm volatile("s_waitcnt vmcnt(0)" ::: "memory");
            __syncthreads();
        }
        KP_LAUNDER();
        {
            PH_SC();
            pg8::Gemm g{WSP(bf16_t, WS_ACT), WSP(bf16_t, WS_WDN) + (size_t)l * D * FH, FH, FH, FH, 0, 0}; pg8::StaticOrder S; S.init(NPR, D, G, bx);
            pg8::EpiBf16 E{kp, 1};
            pg8::gemm_phase<pg8::EpiBf16, true, pg8::StaticOrder>(lds, lds + XCH_OFF, g, S, E, wave0);
        }
        KP_LAUNDER();
        {
            PH_SC();
            pg8::Gemm g{WSP(bf16_t, WS_ACT), WSP(bf16_t, WS_WDN) + (size_t)l * D * FH, 256, FH, FH, 0, 256}; pg8::SliceOrder<11, 4> S{bx};
            pg8::EpiBf16 E{kp, 2};
            pg8::gemm_phase<pg8::EpiBf16, true, pg8::SliceOrder<11, 4>>(lds, lds + XCH_OFF, g, S, E, wave0);
        }
}

template <int l>
__device__ __forceinline__ void ffn_block(kp_t kp, LAS unsigned char* lds, const int wave0) {
        KP_LAUNDER();
        rowa_phase<l>(kp, lds, wave0);
#if defined(REP_ROWA0)
        if (l == 0) { GRID_BAR(); KP_LAUNDER(); rowa_phase<l>(kp, lds, wave0); }
#endif
        GRID_BAR();
        KP_LAUNDER();
#ifndef REP_UP
#define REP_UP 1
#endif
#pragma unroll 1
        for (int rep = 0; rep < REP_UP; ++rep) {
            if (rep) { GRID_BAR(); KP_LAUNDER(); }
            PH_SC();
            pg8::Gemm g{WSP(bf16_t, WS_ABUF), WSP(bf16_t, WS_WUP) + (size_t)l * FU * D, D, D, D, 0, 0}; pg8::StaticOrder S; S.init(MROWS, FU, G, bx);
#ifndef X_NO_CONV
            pg8::EpiConv E{kp, l};
            pg8::gemm_phase<pg8::EpiConv, true, pg8::StaticOrder>(lds, lds + XCH_OFF, g, S, E, wave0);
#else
#endif
        }
        GRID_BAR();
        KP_LAUNDER();
        down_phase<l>(kp, lds, wave0);
#if defined(REP_DOWN)
        GRID_BAR(); KP_LAUNDER();
        down_phase<l>(kp, lds, wave0);
#endif
        GRID_BAR();
        KP_LAUNDER();
        {
            PH_IDS();
            float* Y = KOUT() + O_Y; const float* modl = WSP(float, WS_MOD) + (size_t)l * NCB * 6144;
            row_phase<1, false, (l == 1)>(gw, NGW, lane, nullptr, nullptr, Y, WSP(bf16_t, WS_YB), WSP(bf16_t, WS_MBUF), WSP(bf16_t, WS_PART), modl, 5120, KIN(I_FPOSTG) + l * D,
                      WSP(float, WS_MOD) + (size_t)NCB * 6144, 0, 1024, KIN(I_MPREG) + D, l == 0 ? WSP(bf16_t, WS_ABUF2) : nullptr);
        }
}

__device__ __forceinline__ void p0_phase(kp_t kp, LAS unsigned char* lds, const int wave0) {
        PH_IDS();
        LAS float* scr = (LAS float*)(lds + wave * 16384);
        constexpr int I_AD = 16 * 192;
        for (int it = gw; it < 2 * I_AD; it += NGW) {
            int r = it; const int l = r / I_AD; r -= l * I_AD; const int kb = r / 192, nb = r % 192;
            transpose_item(KIN(I_ADAW) + (size_t)l * D * 6144, 6144, 64 * kb, 32 * nb, WSP(bf16_t, WS_ADAT), D, l * 6144 + 32 * nb, scr, lane);
        }
        KP_LAUNDER();
        {
            const float* cpp = KIN(I_CP); const float* csp = KIN(I_CS); bf16_t* AADA = WSP(bf16_t, WS_AADA);
            for (int i = bx * 512 + tid; i < 256 * D / 4; i += G * 512) {
                const int row = i / (D / 4), c = (i % (D / 4)) * 4;
                u32x2 w = (u32x2){0u, 0u};
                if (row < NCB) { const float* cp = row < 8 ? cpp + (size_t)row * D + c : csp + (size_t)(row - 8) * D + c; const f32x4 v = *(const f32x4*)cp;
                    w.x = cvt_pk_bf16(v[0] * sigmoidf_(v[0]), v[1] * sigmoidf_(v[1])); w.y = cvt_pk_bf16(v[2] * sigmoidf_(v[2]), v[3] * sigmoidf_(v[3])); }
                *(u32x2*)(AADA + (size_t)row * D + c) = w;
            }
        }
        KP_LAUNDER();
        {
            const float* xpp = KIN(I_XP); const float* xsp = KIN(I_XS); float* RSTD0 = WSP(float, WS_RSTD0);
            for (int row = gw; row < MROWS; row += NGW) {
                const float* xr = row < NPR ? xpp + (size_t)row * D : xsp + (size_t)(row - NPR) * D;
                float ss = 0.f;
#pragma unroll
                for (int j = 0; j < 4; ++j) { const f32x4 v = *(const f32x4*)(xr + 4 * lane + 256 * j); ss += (v[0] * v[0] + v[1] * v[1]) + (v[2] * v[2] + v[3] * v[3]); }
                ss = wave_sum(ss);
                if (lane == 0) RSTD0[row] = 1.0f / sqrtf(ss * (1.0f / D) + EPS);
            }
        }
        KP_LAUNDER();
        {
            bf16_t* BBT = WSP(bf16_t, WS_BBT); float* LBR = WSP(float, WS_LBR); float* LBI = WSP(float, WS_LBI);
            for (int i = bx * 512 + tid; i < 64 * 64; i += G * 512) {
                const int g = i >> 6;
                const double are = KIN(I_ARE)[i], aim = KIN(I_AIM)[i];
                const double dt = (double)expf(KIN(I_LOGDT)[g]);
                const double mag = exp(are * dt); double sn, cs; sincos_d(aim * dt, sn, cs);
                const double lr = mag * cs, li = mag * sn;
                LBR[i] = (float)lr; LBI[i] = (float)li;
                const double nr = lr - 1.0, ni = li, den = are * are + aim * aim;
                const float fre = (float)((nr * are + ni * aim) / den), fim = (float)((ni * are - nr * aim) / den);
                const float* bre = KIN(I_BRE) + (size_t)i * 16; const float* bim = KIN(I_BIM) + (size_t)i * 16;
                const int p = i & 63;
#pragma unroll
                for (int c = 0; c < 16; c += 2) {
                    const float r0 = fre * bre[c] - fim * bim[c], r1 = fre * bre[c + 1] - fim * bim[c + 1];
                    const float i0 = fre * bim[c] + fim * bre[c], i1 = fre * bim[c + 1] + fim * bre[c + 1];
                    *(unsigned*)(BBT + ((size_t)(g * 128 + p) * 16 + c)) = cvt_pk_bf16(r0, r1);
                    *(unsigned*)(BBT + ((size_t)(g * 128 + 64 + p) * 16 + c)) = cvt_pk_bf16(i0, i1);
                }
            }
        }
        KP_LAUNDER();
        {
            bf16_t* CMT = WSP(bf16_t, WS_CMT); const float* cre = KIN(I_CRE); const float* cim = KIN(I_CIM); const float* sd = KIN(I_SD);
            for (int i = bx * 512 + tid; i < 64 * 16 * 160; i += G * 512) {
                const int k = i % 160, gc = i / 160, c = gc & 15;
                float v = 0.f;
                if (k < 128) v = (k & 1) ? -cim[(size_t)gc * 64 + (k >> 1)] : cre[(size_t)gc * 64 + (k >> 1)];
                else if (k - 128 == c) v = sd[gc];
                CMT[i] = (bf16_t)(cvt_pk_bf16(v, 0.f) & 0xffffu);
            }
        }
}

__device__ __forceinline__ void p1_phase(kp_t kp, LAS unsigned char* lds, const int wave0) {
    {
        PH_IDS();
        constexpr int NADA = 48;
        if (bx < NADA || G <= NADA) {
            pg8::Gemm g{WSP(bf16_t, WS_AADA), WSP(bf16_t, WS_ADAT), D, D, D, 0, 0}; pg8::StaticOrder S; S.init(256, 2 * 6144, G, bx);
            pg8::EpiAda E{kp};
            pg8::gemm_phase<pg8::EpiAda, true, pg8::StaticOrder>(lds, lds + XCH_OFF, g, S, E, wave0);
        }
        if (bx >= NADA || G <= NADA) {
            LAS float* scr = (LAS float*)(lds + wave * 16384);
            constexpr int I_UP = 16 * 176, I_DN = 44 * 32, I_GL = 16 * 32, I_PL = 4 * 8;
            constexpr int NITEMS = 2 * I_UP + 2 * I_DN + 2 * I_GL + 4 * I_PL;
            const int w0 = (G <= NADA) ? bx * 8 + wave : (bx - NADA) * 8 + wave, nw = (G <= NADA) ? G * 8 : (G - NADA) * 8;
            for (int it = w0; it < NITEMS; it += nw) {
                int r = it;
                if (r < 2 * I_UP) { const int l = r / I_UP; r -= l * I_UP; const int kb = r / 176, nb = r % 176; const int n0 = 32 * nb, bj = n0 >= FH, nn = n0 - bj * FH;
                    transpose_item(KIN(I_WUP) + (size_t)l * D * FU, FU, 64 * kb, n0, WSP(bf16_t, WS_WUP) + (size_t)l * FU * D, D, 256 * (nn / 128) + 128 * bj + (nn % 128), scr, lane); continue; }
                r -= 2 * I_UP;
                if (r < 2 * I_DN) { const int l = r / I_DN; r -= l * I_DN; const int kb = r / 32, nb = r % 32;
                    transpose_item(KIN(I_WDN) + (size_t)l * FH * D, D, 64 * kb, 32 * nb, WSP(bf16_t, WS_WDN) + (size_t)l * D * FH, FH, 32 * nb, scr, lane); continue; }
                r -= 2 * I_DN;
                if (r < 2 * I_GL) { const int bj = r / I_GL; r -= bj * I_GL; const int kb = r / 32, nb = r % 32; const int n0 = 32 * nb;
                    transpose_item(KIN(bj ? I_GLUB : I_GLUA), D, 64 * kb, n0, WSP(bf16_t, WS_WGLU), D, 256 * (n0 / 128) + 128 * bj + (n0 % 128), scr, lane); continue; }
                r -= 2 * I_GL;
                { const int g = r / I_PL; r -= g * I_PL; const int kb = r / 8, nb = r % 8;
                    transpose_item(KIN(I_POOLW) + (size_t)g * 256 * 256, 256, 64 * kb, 32 * nb, WSP(bf16_t, WS_WPOOL), 256, g * 256 + 32 * nb, scr, lane); }
            }
        }
    }
}

__device__ __forceinline__ void poolprep_phase(kp_t kp, LAS unsigned char* lds, const int wave0) {
            {
                PH_IDS();
                const int hw = bx * 2 + (tid >> 8), tq = tid & 255, c4 = 4 * tq, wv = tq >> 6;
                const float* xp = KIN(I_XP); const float* xs = KIN(I_XS); const float* spool = KIN(I_SPOOL); const float* g0 = KIN(I_MPREG);
                float* opp = KOUT() + O_POOLP; float* ops = KOUT() + O_POOLS;
                const float* RSTD0 = WSP(float, WS_RSTD0); const float* modl = WSP(float, WS_MOD); bf16_t* ABUF = WSP(bf16_t, WS_ABUF);
                for (int it = hw; it < 512; it += 2 * G) {
                    if (wv == 0) pool_item<2, false>(it, c4, xp, xs, spool, RSTD0, modl, g0, ABUF, opp, ops);
                    else if (wv == 1) pool_item<4, false>(it, c4, xp, xs, spool, RSTD0, modl, g0, ABUF, opp, ops);
                    else if (wv == 2) pool_item<8, false>(it, c4, xp, xs, spool, RSTD0, modl, g0, ABUF, opp, ops);
                    else pool_item<16, false>(it, c4, xp, xs, spool, RSTD0, modl, g0, ABUF, opp, ops);
                }
                for (int is = (2 * G - 1 - hw); is < 128; is += 2 * G) {
                    if (wv == 0) pool_item<2, true>(is, c4, xp, xs, spool, RSTD0, modl, g0, ABUF, opp, ops);
                    else if (wv == 1) pool_item<4, true>(is, c4, xp, xs, spool, RSTD0, modl, g0, ABUF, opp, ops);
                    else if (wv == 2) pool_item<8, true>(is, c4, xp, xs, spool, RSTD0, modl, g0, ABUF, opp, ops);
                    else pool_item<16, true>(is, c4, xp, xs, spool, RSTD0, modl, g0, ABUF, opp, ops);
                }
            }
}

__device__ __forceinline__ void poolgemm_phase(kp_t kp, LAS unsigned char* lds, const int wave0) {
            {
                PH_SC();
                pg8::Gemm g{WSP(bf16_t, WS_ABUF), WSP(bf16_t, WS_WPOOL), 256, D, 256, 256, 0}; pg8::StaticOrder S; S.init(MROWS, D, G, bx);
                pg8::EpiBf16 E{kp, 0};
                pg8::gemm_phase<pg8::EpiBf16, true, pg8::StaticOrder>(lds, lds + XCH_OFF, g, S, E, wave0);
            }
}

__device__ __forceinline__ void s5_phases(kp_t kp, LAS unsigned char* lds, const int wave0) {
                {
                    PH_IDS();
                    LAS float* T = (LAS float*)(lds + wave * S5_WAVE_BYTES);
                    const bf16_t* HB = WSP(bf16_t, WS_ABUF2); bf16_t* GYB = WSP(bf16_t, WS_ABUF);
                    const bf16_t* BBT = WSP(bf16_t, WS_BBT); const bf16_t* CMT = WSP(bf16_t, WS_CMT); const float* LBR = WSP(float, WS_LBR); const float* LBI = WSP(float, WS_LBI);
                    float* CARRY = WSP(float, WS_BND);
                    if (wave < 6) {
                        for (int u = vcu * 6 + wave; u < 512 * 3; u += 6 * G)
                            s5_unit<2>(u, lane, T, HB, GYB, BBT, CMT, LBR, LBI, nullptr, nullptr, nullptr, nullptr, CARRY);
                    } else {
                        for (int u = vcu * 2 + (wave - 6); u < 2048; u += 2 * G)
                            s5_unit<1>(u, lane, T, HB, GYB, BBT, CMT, LBR, LBI, KIN(I_SSRE), KIN(I_SSIM), KOUT() + O_SRES, KOUT() + O_SIMS, nullptr);
                    }
                }
                GRID_BAR();
                KP_LAUNDER();
                {
                    PH_IDS();
                    LAS float* T = (LAS float*)(lds + wave * S5_WAVE_BYTES);
                    const bf16_t* HB = WSP(bf16_t, WS_ABUF2); bf16_t* GYB = WSP(bf16_t, WS_ABUF);
                    const bf16_t* BBT = WSP(bf16_t, WS_BBT); const bf16_t* CMT = WSP(bf16_t, WS_CMT); const float* LBR = WSP(float, WS_LBR); const float* LBI = WSP(float, WS_LBI);
                    float* CARRY = WSP(float, WS_BND);
                    for (int u = gw; u < 512 * 4; u += NGW)
                        s5_unit<0>(u, lane, T, HB, GYB, BBT, CMT, LBR, LBI, nullptr, nullptr, KOUT() + O_SREP, KOUT() + O_SIMP, CARRY);
                }
}

__device__ __forceinline__ void glu_phase(kp_t kp, LAS unsigned char* lds, const int wave0) {
            {
                PH_SC();
                pg8::Gemm g{WSP(bf16_t, WS_ABUF), WSP(bf16_t, WS_WGLU), D, D, D, 0, 0}; pg8::StaticOrder S; S.init(NPR, 2 * D, G, bx);
                pg8::EpiGlu E{kp};
                pg8::gemm_phase<pg8::EpiGlu, true, pg8::StaticOrder>(lds, lds + XCH_OFF, g, S, E, wave0);
            }
            KP_LAUNDER();
            {
                PH_SC();
                pg8::Gemm g{WSP(bf16_t, WS_ABUF), WSP(bf16_t, WS_WGLU), 256, D, D, 0, 256}; pg8::SliceOrder<4, 8> S{bx};
                pg8::EpiBf16 E{kp, 3};
                pg8::gemm_phase<pg8::EpiBf16, true, pg8::SliceOrder<4, 8>>(lds, lds + XCH_OFF, g, S, E, wave0);
            }
}

__device__ __forceinline__ void forward_all(kp_t kp, LAS unsigned char* lds, const int wave0) {
    p0_phase(kp, lds, wave0);
#if defined(REP_P0)
    GRID_BAR(); KP_LAUNDER(); p0_phase(kp, lds, wave0);
#endif
    GRID_BAR();
    if (gridDim.x == 0x7ffffffu) cg::this_grid().sync();
    KP_LAUNDER();
    p1_phase(kp, lds, wave0);
#if defined(REP_P1)
    GRID_BAR(); KP_LAUNDER(); p1_phase(kp, lds, wave0);
#endif
    GRID_BAR(); KP_LAUNDER();
    poolprep_phase(kp, lds, wave0);
#if defined(REP_POOLP)
    GRID_BAR(); KP_LAUNDER(); poolprep_phase(kp, lds, wave0);
#endif
    GRID_BAR(); KP_LAUNDER();
    poolgemm_phase(kp, lds, wave0);
#if defined(REP_POOLG)
    GRID_BAR(); KP_LAUNDER(); poolgemm_phase(kp, lds, wave0);
#endif
    GRID_BAR();
    ffn_block<0>(kp, lds, wave0);
    GRID_BAR(); KP_LAUNDER();
    s5_phases(kp, lds, wave0);
#if defined(REP_S5)
    GRID_BAR(); KP_LAUNDER(); s5_phases(kp, lds, wave0);
#endif
    GRID_BAR(); KP_LAUNDER();
    glu_phase(kp, lds, wave0);
#if defined(REP_GLU)
    GRID_BAR(); KP_LAUNDER(); glu_phase(kp, lds, wave0);
#endif
    GRID_BAR();
    ffn_block<1>(kp, lds, wave0);
}

__global__ void __launch_bounds__(512, 2) mega_fwd(Args a_unused) {
    extern __shared__ __attribute__((aligned(16))) unsigned char lds_raw[];
    LAS unsigned char* lds = (LAS unsigned char*)lds_raw;
    volatile LAS unsigned* MISC = (volatile LAS unsigned*)(lds + MISC_OFF);
    const int tid0 = threadIdx.x;
    const int wave0 = __builtin_amdgcn_readfirstlane(tid0 >> 6);
    kp_t kp = (kp_t)__builtin_amdgcn_kernarg_segment_ptr();
    KP_LAUNDER();
    if (tid0 < 64) MISC[tid0] = 0u;
    __syncthreads();
    (void)xcd_barrier_post((unsigned*)(KWS() + WS_CTL) + CW_BAR, MISC + 8);

    forward_all(kp, lds, wave0);
#ifdef REP_ALL
    GRID_BAR(); KP_LAUNDER();
    forward_all(kp, lds, wave0);
#endif
}

extern "C" void kernel_launch(void* const* d_in, const int* in_sizes, int n_in, void* d_out, int out_size, void* d_ws, size_t ws_size, hipStream_t stream) {
    static int grid = 0;
    if (grid == 0) {
        if (n_in != 30 || ws_size < WS_END) { fprintf(stderr, "kernel_launch: unexpected n_in %d / ws %zu\n", n_in, ws_size); grid = -1; return; }
        int dev = 0, cus = 0, per_cu = 0;
        hipGetDevice(&dev); hipDeviceGetAttribute(&cus, hipDeviceAttributeMultiprocessorCount, dev);
        if (hipFuncSetAttribute((const void*)mega_fwd, hipFuncAttributeMaxDynamicSharedMemorySize, LDS_BYTES) != hipSuccess) { fprintf(stderr, "kernel_launch: hipFuncSetAttribute failed\n"); grid = -1; return; }
        if (hipOccupancyMaxActiveBlocksPerMultiprocessor(&per_cu, (const void*)mega_fwd, 512, LDS_BYTES) != hipSuccess || per_cu < 1) { fprintf(stderr, "kernel_launch: occupancy query %d\n", per_cu); per_cu = 1; }
        (void)hipGetLastError();
        grid = cus;
    }
    if (grid < 0) return;
    hipMemsetAsync((char*)d_ws + WS_CTL, 0, CTL_ZERO_BYTES, stream);
    Args a{};
    for (int i = 0; i < 30; ++i) a.in[i] = (const float*)d_in[i];
    a.out = (float*)d_out; a.ws = (unsigned char*)d_ws;
    void* args[] = {&a};
    hipError_t e = hipLaunchCooperativeKernel((const void*)mega_fwd, dim3(grid), dim3(512), args, LDS_BYTES, stream);
    if (e != hipSuccess) fprintf(stderr, "cooperative launch failed: %s (grid %d)\n", hipGetErrorString(e), grid);
}
```

```cpp
#include <hip/hip_runtime.h>
#include <hip/hip_cooperative_groups.h>
#include <cstdio>
#include <cstdint>
namespace cg = cooperative_groups;

#define LAS __attribute__((address_space(3)))
typedef unsigned short bf16_t;
typedef short bf16x8 __attribute__((ext_vector_type(8)));
typedef float f32x4 __attribute__((ext_vector_type(4)));
typedef float f32x2 __attribute__((ext_vector_type(2)));
typedef float f32x16 __attribute__((ext_vector_type(16)));
typedef unsigned u32x4 __attribute__((ext_vector_type(4)));
typedef unsigned u32x2 __attribute__((ext_vector_type(2)));

constexpr int D = 1024, NPR = 16384, NSR = 1024, MROWS = NPR + NSR, FH = 2816, FU = 5632;
constexpr int SEQ = 2048, NCB = 136;
constexpr float EPS = 1e-6f;
constexpr int NMT = MROWS / 256;
constexpr size_t O_Y = 0, O_POOLP = 17825792, O_POOLS = O_POOLP + 122880, O_SREP = O_POOLS + 1966080, O_SIMP = O_SREP + 32768,
                 O_SRES = O_SIMP + 32768, O_SIMS = O_SRES + 524288, O_CONVP = O_SIMS + 524288, O_CONVS = O_CONVP + 180224;
constexpr size_t MiB = 1u << 20;
constexpr size_t WS_CTL = 0, CTL_ZERO_BYTES = 65536;
constexpr size_t WS_WUP = 1 * MiB, WS_WDN = 23 * MiB, WS_WGLU = 34 * MiB, WS_WPOOL = 38 * MiB, WS_AADA = 38 * MiB + 512 * 1024, WS_MOD = 39 * MiB;
constexpr size_t WS_SMALL = 46 * MiB, WS_BBT = WS_SMALL, WS_CMT = WS_BBT + 262144, WS_LBR = WS_CMT + 327680, WS_LBI = WS_LBR + 16384, WS_RSTD0 = WS_LBI + 16384;
constexpr size_t WS_BND = 47 * MiB, WS_ABUF = 54 * MiB, WS_MBUF = 88 * MiB, WS_ACT = 122 * MiB, WS_ADAT = 122 * MiB, WS_ABUF2 = 146 * MiB;
constexpr size_t WS_PART = WS_ABUF;
constexpr size_t WS_PARTG = 186 * MiB;
constexpr size_t WS_YB = 216 * MiB;
constexpr size_t WS_END = 250 * MiB;
constexpr int NKS = 11, NKG = 4;
constexpr int CW_BAR = 1024;
constexpr int RING_BYTES = 131072, XCH_OFF = 131072, XCH_BYTES = 8192, MISC_OFF = XCH_OFF + XCH_BYTES, LDS_BYTES = MISC_OFF + 256;
constexpr int S5_LD = 132, S5_WAVE_BYTES = 32 * S5_LD * 4;
static_assert(8 * S5_WAVE_BYTES <= MISC_OFF, "s5 lds");

__device__ __forceinline__ unsigned cvt_pk_bf16(float lo, float hi) { unsigned r; asm volatile("v_cvt_pk_bf16_f32 %0, %1, %2" : "=v"(r) : "v"(lo), "v"(hi)); return r; }
__device__ __forceinline__ f32x4 ldnt4(const float* p) { return __builtin_nontemporal_load((const f32x4*)p); }
__device__ __forceinline__ u32x2 ldnt2u(const bf16_t* p) { return __builtin_nontemporal_load((const u32x2*)p); }
__device__ __forceinline__ void stnt4(float* p, f32x4 v) { __builtin_nontemporal_store(v, (f32x4*)p); }
__device__ __forceinline__ float bf2f(unsigned short b) { return __builtin_bit_cast(float, (unsigned)b << 16); }
__device__ __forceinline__ float wave_sum(float v) {
#pragma unroll
    for (int o = 1; o < 64; o <<= 1) v += __shfl_xor(v, o);
    return v;
}
__device__ __forceinline__ f32x2 gelu_pk(f32x2 v) {
    const f32x2 av = __builtin_elementwise_abs(v), d = av * 0.2316418882f + 1.0f;
    f32x2 t; t.x = __builtin_amdgcn_rcpf(d.x); t.y = __builtin_amdgcn_rcpf(d.y);
    f32x2 q = t * 0.5307027145f + (-0.7265760135f); q = q * t + 0.7107068705f; q = q * t + (-0.142248368f); q = q * t + 0.127414796f; q = q * t;
    const f32x2 s = (v * v) * (-0.72134752044f);
    f32x2 e; e.x = __builtin_amdgcn_exp2f(s.x); e.y = __builtin_amdgcn_exp2f(s.y);
    const f32x2 m = v * (q * e), r = v - m;
    f32x2 o; o.x = v.x < 0.f ? m.x : r.x; o.y = v.y < 0.f ? m.y : r.y; return o;
}
__device__ __forceinline__ float gelu1(float x) { f32x2 r = gelu_pk((f32x2){x, 0.f}); return r.x; }
__device__ __forceinline__ float sigmoidf_(float x) { return __builtin_amdgcn_rcpf(1.0f + __builtin_amdgcn_exp2f(x * -1.44269504089f)); }
__device__ __forceinline__ float dpp_ror1(float x) { return __builtin_bit_cast(float, __builtin_amdgcn_update_dpp(0, __builtin_bit_cast(int, x), 0x121, 0xF, 0xF, false)); }
__device__ __forceinline__ float dpp_ror2(float x) { return __builtin_bit_cast(float, __builtin_amdgcn_update_dpp(0, __builtin_bit_cast(int, x), 0x122, 0xF, 0xF, false)); }
__device__ __forceinline__ float dpp_shr1z(float x) { return __builtin_bit_cast(float, __builtin_amdgcn_update_dpp(0, __builtin_bit_cast(int, x), 0x111, 0xF, 0xF, true)); }
__device__ __forceinline__ f32x4 shr1z(f32x4 v) { return (f32x4){dpp_shr1z(v[0]), dpp_shr1z(v[1]), dpp_shr1z(v[2]), dpp_shr1z(v[3])}; }
__device__ __forceinline__ f32x4 ror1v(f32x4 v) { return (f32x4){dpp_ror1(v[0]), dpp_ror1(v[1]), dpp_ror1(v[2]), dpp_ror1(v[3])}; }
__device__ __forceinline__ f32x4 ror2v(f32x4 v) { return (f32x4){dpp_ror2(v[0]), dpp_ror2(v[1]), dpp_ror2(v[2]), dpp_ror2(v[3])}; }

typedef const float* __attribute__((address_space(4))) const* karg_tab_t;
typedef const __attribute__((address_space(4))) unsigned char* kp_t;
#define KP_LAUNDER() asm volatile("" : "+s"(kp))
#define KIN(i) ((const float*)(((karg_tab_t)kp)[i]))
#define KOUT() ((float*)(((karg_tab_t)kp)[30]))
#define KWS() ((unsigned char*)(((karg_tab_t)kp)[31]))
#define WSP(T, off) ((T*)(KWS() + (off)))
enum { I_XP = 0, I_XS, I_CP, I_CS, I_SPOOL, I_SSRE, I_SSIM, I_SCONV, I_ADAW, I_ADAB, I_MPREG, I_MPOSTG, I_FPREG, I_FPOSTG, I_POOLW, I_POOLSC,
       I_ARE, I_AIM, I_LOGDT, I_BRE, I_BIM, I_CRE, I_CIM, I_SD, I_GLUA, I_GLUB, I_WUP, I_CONVW, I_CONVB, I_WDN };
__device__ __forceinline__ int hw_lane() { return (int)__builtin_amdgcn_mbcnt_hi(~0u, __builtin_amdgcn_mbcnt_lo(~0u, 0u)); }
namespace pg8 {
constexpr int BM = 256, BK = 64, HALF = 128, HTB = HALF * BK * 2, NXCD = 8, WGM = 8;
__host__ __device__ __forceinline__ int lds_byte(int r, int c) { const int st = (r >> 4) * 2 + (c >> 5), rr = r & 15, cc = c & 31, ob = rr * 64 + cc * 2; return st * 1024 + (ob ^ (((ob >> 9) & 1) << 5)); }
__host__ __device__ __forceinline__ void stage_rc(int b, int& R, int& C) { const int st = b / 1024, sb = b % 1024, swz = sb ^ (((sb >> 9) & 1) << 5); R = (st >> 1) * 16 + swz / 64; C = (st & 1) * 32 + (swz % 64) / 2; }
__host__ __device__ __forceinline__ int perm32(int rho) { const int n = rho >> 4, i = rho & 15; return 8 * (i >> 2) + 4 * n + (i & 3); }
struct Unit { int pm, pn, ks; };
struct Gemm { const bf16_t* A; const bf16_t* Bt; int K, lda, ldb, a_pn_off, k_slice; };
struct StaticOrder {
    int nM, nN, nwg, G, c;
    __device__ void init(int M, int N, int G_, int c_) { nM = M / BM; nN = N / BM; nwg = nM * nN; G = G_; c = c_; }
    __device__ bool next(int i, Unit& u) const {
        const long L = (long)i * G + c; if (L >= nwg) return false;
        int wgid = (int)L; { const int q = nwg / NXCD, r = nwg % NXCD, xcd = wgid % NXCD, off = wgid / NXCD; wgid = (xcd < r ? xcd * (q + 1) : r * (q + 1) + (xcd - r) * q) + off; }
        const int nig = WGM * nN, gid = wgid / nig, fm = gid * WGM, gsz = (nM - fm) < WGM ? (nM - fm) : WGM;
        u.pm = fm + ((wgid % nig) % gsz); u.pn = (wgid % nig) / gsz; u.ks = 0; return true;
    }
};
template <int NS, int NN>
struct SliceOrder {
    int c;
    __device__ bool next(int i, Unit& u) const { if (i != 0 || c >= 4 * NN * NS) return false; const int su = c / NS; u.pm = 64 + su / NN; u.pn = su % NN; u.ks = c % NS; return true; }
};

struct EpiAda {
    static constexpr bool PERM = false;
    kp_t kp0;
    __device__ __forceinline__ void operator()(const f32x4 (&acc)[2][2][4][2], const Unit& u, int wr, int wc, int fr, int fq, LAS unsigned char*) const {
        kp_t kp = kp0; KP_LAUNDER();
        const float* bias = KIN(I_ADAB);
        int colt = u.pn * BM; const int t = colt / 6144; float* base = WSP(float, WS_MOD) + (size_t)t * NCB * 6144; colt -= t * 6144;
#pragma unroll
        for (int bj = 0; bj < 2; ++bj)
#pragma unroll
            for (int n = 0; n < 2; ++n) {
                const int cl = bj * HALF + wc * 32 + n * 16 + 4 * fq;
                const f32x4 bv = *(const f32x4*)(bias + u.pn * BM + cl);
#pragma unroll
                for (int ai = 0; ai < 2; ++ai)
#pragma unroll
                    for (int m = 0; m < 4; ++m) {
                        const int row = u.pm * BM + ai * HALF + wr * 64 + m * 16 + fr;
                        if (row < NCB) *(f32x4*)(base + (size_t)row * 6144 + colt + cl) = acc[ai][bj][m][n] + bv;
                    }
            }
    }
};
struct EpiBf16 {
    static constexpr bool PERM = true;
    kp_t kp0; int mode;
    __device__ __forceinline__ void operator()(const f32x4 (&acc)[2][2][4][2], const Unit& u, int wr, int wc, int fr, int fq, LAS unsigned char*) const {
        kp_t kp = kp0; KP_LAUNDER();
        const float* scale = mode == 0 ? KIN(I_POOLSC) : nullptr;
        bf16_t* base = mode == 2 ? WSP(bf16_t, WS_PART) + (size_t)u.ks * NSR * D : mode == 3 ? WSP(bf16_t, WS_PARTG) + (size_t)u.ks * NSR * 2 * D : WSP(bf16_t, WS_MBUF);
        const int row_off = mode >= 2 ? NPR : 0, ldc = mode == 3 ? 2 * D : D;
#pragma unroll
        for (int bj = 0; bj < 2; ++bj) {
            const int col = u.pn * BM + bj * HALF + wc * 32 + 8 * fq;
            f32x4 s0 = (f32x4){1.f, 1.f, 1.f, 1.f}, s1 = s0;
            if (scale) { s0 = *(const f32x4*)(scale + col); s1 = *(const f32x4*)(scale + col + 4); }
#pragma unroll
            for (int ai = 0; ai < 2; ++ai)
#pragma unroll
                for (int m = 0; m < 4; ++m) {
                    const int row = u.pm * BM + ai * HALF + wr * 64 + m * 16 + fr - row_off;
                    const f32x4 v0 = acc[ai][bj][m][0] * s0, v1 = acc[ai][bj][m][1] * s1;
                    u32x4 w; w.x = cvt_pk_bf16(v0[0], v0[1]); w.y = cvt_pk_bf16(v0[2], v0[3]); w.z = cvt_pk_bf16(v1[0], v1[1]); w.w = cvt_pk_bf16(v1[2], v1[3]);
                    *(u32x4*)(base + (size_t)row * ldc + col) = w;
                }
        }
    }
};
struct EpiGlu {
    static constexpr bool PERM = true;
    kp_t kp0;
    __device__ __forceinline__ void operator()(const f32x4 (&acc)[2][2][4][2], const Unit& u, int wr, int wc, int fr, int fq, LAS unsigned char*) const {
        kp_t kp = kp0; KP_LAUNDER();
        bf16_t* out = WSP(bf16_t, WS_MBUF);
        const int col = u.pn * HALF + wc * 32 + 8 * fq;
#pragma unroll
        for (int ai = 0; ai < 2; ++ai)
#pragma unroll
            for (int m = 0; m < 4; ++m) {
                const int row = u.pm * BM + ai * HALF + wr * 64 + m * 16 + fr;
                float o[8];
#pragma unroll
                for (int n = 0; n < 2; ++n)
#pragma unroll
                    for (int e = 0; e < 4; ++e) o[4 * n + e] = acc[ai][0][m][n][e] * sigmoidf_(acc[ai][1][m][n][e]);
                u32x4 w; w.x = cvt_pk_bf16(o[0], o[1]); w.y = cvt_pk_bf16(o[2], o[3]); w.z = cvt_pk_bf16(o[4], o[5]); w.w = cvt_pk_bf16(o[6], o[7]);
                *(u32x4*)(out + (size_t)row * D + col) = w;
            }
    }
};
struct EpiConv {
    static constexpr bool PERM = true, APERM = true;
    kp_t kp0; int l;
    __device__ __forceinline__ void operator()(const f32x4 (&acc)[2][2][4][2], const Unit& u, int wr, int wc, int fr, int fq, LAS unsigned char* xl) const {
        kp_t kp = kp0; KP_LAUNDER();
        bf16_t* act = WSP(bf16_t, WS_ACT); float* bnd = WSP(float, WS_BND); const float* cw = KIN(I_CONVW) + (size_t)l * 3 * FU; const float* cb = KIN(I_CONVB) + (size_t)l * FU;
        const float* cstate = KIN(I_SCONV) + (size_t)l * 128 * 2 * FU; float* ncs = KOUT() + O_CONVS + (size_t)l * 128 * 2 * FU;
        LAS float* X = (LAS float*)xl;
        const int jl = wc * 32 + 8 * fq;
        const bool sample = u.pm >= (NPR / 256);
#pragma unroll
        for (int ai = 0; ai < 2; ++ai)
#pragma unroll
            for (int bj = 0; bj < 2; ++bj)
#pragma unroll
                for (int n = 0; n < 2; ++n) {
                    const int oc = bj * FH + u.pn * HALF + jl + 4 * n;
                    if (fr == 15) {
                        LAS float* xb = X + ((((ai * 2 + wr) * 2) * 2 + bj) * 128 + jl + 4 * n);
                        *(LAS f32x4*)(xb) = acc[ai][bj][2][n]; *(LAS f32x4*)(xb + 2 * 128) = acc[ai][bj][3][n];
                        if (ai == 1 && wr == 1) { *(f32x4*)(bnd + ((size_t)u.pm * 4 + 2) * FU + oc) = acc[1][bj][2][n]; *(f32x4*)(bnd + ((size_t)u.pm * 4 + 3) * FU + oc) = acc[1][bj][3][n]; }
                    }
                    if (ai == 0 && wr == 0 && fr == 0) { *(f32x4*)(bnd + ((size_t)u.pm * 4 + 0) * FU + oc) = acc[0][bj][0][n]; *(f32x4*)(bnd + ((size_t)u.pm * 4 + 1) * FU + oc) = acc[0][bj][1][n]; }
                }
        asm volatile("s_waitcnt lgkmcnt(0)" ::: "memory"); __builtin_amdgcn_s_barrier(); asm volatile("" ::: "memory");
        u32x2 pk0[2][4];
#pragma unroll
        for (int n = 0; n < 2; ++n) {
            const int j = u.pn * HALF + jl + 4 * n;
            f32x4 w0[2], w1[2], w2[2], bb[2];
#pragma unroll
            for (int bj = 0; bj < 2; ++bj) { const int oc = bj * FH + j; w0[bj] = *(const f32x4*)(cw + oc); w1[bj] = *(const f32x4*)(cw + FU + oc); w2[bj] = *(const f32x4*)(cw + 2 * FU + oc); bb[bj] = *(const f32x4*)(cb + oc); }
#pragma unroll
            for (int ai = 0; ai < 2; ++ai) {
                const int row0 = u.pm * BM + ai * HALF + wr * 64 + 4 * fr;
                f32x4 P3[2], P2[2];
#pragma unroll
                for (int bj = 0; bj < 2; ++bj) {
                    const f32x4 d3 = shr1z(acc[ai][bj][3][n]), d2 = shr1z(acc[ai][bj][2][n]);
                    f32x4 e3 = (f32x4){0.f, 0.f, 0.f, 0.f}, e2 = e3;
                    bool edge;
                    if (!sample) {
                        edge = (fr == 0);
                        if (edge && !(ai == 0 && wr == 0)) {
                            const int pai = wr ? ai : ai - 1, pwr = wr ? 0 : 1;
                            LAS float* xb = X + (((pai * 2 + pwr) * 2) * 2 + bj) * 128 + jl + 4 * n;
                            e2 = *(LAS f32x4*)(xb); e3 = *(LAS f32x4*)(xb + 2 * 128);
                        }
                    } else {
                        edge = ((fr & 1) == 0);
                        if (edge) { const int b = (row0 - NPR) >> 3; const float* sp = cstate + (size_t)b * 2 * FU + bj * FH + j; e2 = *(const f32x4*)(sp); e3 = *(const f32x4*)(sp + FU); }
                    }
                    P3[bj] = edge ? e3 : d3; P2[bj] = edge ? e2 : d2;
                }
#pragma unroll
                for (int m = 0; m < 4; ++m) {
                    const int row = row0 + m;
                    f32x4 cv[2];
#pragma unroll
                    for (int bj = 0; bj < 2; ++bj) {
                        const f32x4 v = acc[ai][bj][m][n];
                        const f32x4 p1 = m == 0 ? P3[bj] : acc[ai][bj][m ? m - 1 : 0][n];
                        const f32x4 p2 = m == 0 ? P2[bj] : (m == 1 ? P3[bj] : acc[ai][bj][m >= 2 ? m - 2 : 0][n]);
                        if (sample && (fr & 1) && m >= 2) { const int b = (row0 - NPR) >> 3; stnt4(ncs + ((size_t)b * 2 + (m - 2)) * FU + bj * FH + j, v); }
                        cv[bj] = bb[bj] + w0[bj] * p2 + w1[bj] * p1 + w2[bj] * v;
                    }
                    const f32x2 g0 = gelu_pk((f32x2){cv[0][0], cv[0][1]}), g1 = gelu_pk((f32x2){cv[0][2], cv[0][3]});
                    u32x2 w; w.x = cvt_pk_bf16(g0.x * cv[1][0], g0.y * cv[1][1]); w.y = cvt_pk_bf16(g1.x * cv[1][2], g1.y * cv[1][3]);
                    if (n == 0) pk0[ai][m] = w;
                    else { u32x4 o; o.x = pk0[ai][m].x; o.y = pk0[ai][m].y; o.z = w.x; o.w = w.y; *(u32x4*)(act + (size_t)row * FH + u.pn * HALF + jl) = o; }
                }
            }
        }
    }
};

template <class E> struct aperm_of { template <class T> static constexpr auto test(int) -> decltype(T::APERM, true) { return T::APERM; } template <class T> static constexpr bool test(...) { return false; } static constexpr bool value = test<E>(0); };
template <class Epi, bool ALIGN_EPI, class Sched>
__device__ __forceinline__ void gemm_phase(LAS unsigned char* lds, LAS unsigned char* xlds, const Gemm g, const Sched& S, const Epi& E, int wave0) {
    asm volatile("" : "+s"(wave0));
    int tid_l = wave0 * 64 + hw_lane(); asm volatile("" : "+v"(tid_l));
    const int tid = tid_l, wid = wave0, lane = tid & 63, wr = wid >> 2, wc = wid & 3, fr = lane & 15, fq = lane >> 4;
    const int K = g.K, nt = K / BK;
    unsigned voffA[2], voffB[2];
#pragma unroll
    for (int i = 0; i < 2; ++i) { int R, C; stage_rc(tid * 16 + i * 8192, R, C); const int Rb = Epi::PERM ? ((R & ~31) + perm32(R & 31)) : R;
        const int Ra = aperm_of<Epi>::value ? (64 * (R >> 6) + 4 * (R & 15) + ((R >> 4) & 3)) : R;
        voffA[i] = (unsigned)(Ra * g.lda + C) * 2u; voffB[i] = (unsigned)(Rb * g.ldb + C) * 2u; }
    const size_t kstep = (size_t)(BK * 2);
    const size_t hstepA = (size_t)HALF * g.lda * 2, tstepA = 2 * hstepA;
    const size_t hstepB = (size_t)HALF * g.ldb * 2, tstepB = 2 * hstepB;
    const size_t pnoffA = (size_t)g.a_pn_off * 2, ksoff = (size_t)g.k_slice * 2;
    const unsigned ldsw = (unsigned)wid * 1024u;
    const int aoff = lds_byte(wr * 64 + fr, fq * 8), boff = lds_byte(wc * 32 + fr, fq * 8);
#define PG8_SA(b, h) (((b) * 2 + (h)) * HTB)
#define PG8_SB(b, h) ((4 + (b) * 2 + (h)) * HTB)
#define PG8_STAGE(bufoff, gbase, voff) do { _Pragma("unroll") for (int _i = 0; _i < 2; ++_i) \
        __builtin_amdgcn_global_load_lds((const unsigned*)((const char*)(gbase) + (voff)[_i]), (LAS unsigned*)(lds + (bufoff) + ldsw + _i * 8192), 16, 0, 0); } while (0)
#define PG8_LDA(dst, b, h) do { _Pragma("unroll") for (int m = 0; m < 4; ++m) _Pragma("unroll") for (int k = 0; k < 2; ++k) dst[m][k] = *(const LAS bf16x8*)(lds + PG8_SA(b, h) + aoff + m * 2048 + k * 1024); } while (0)
#define PG8_LDB(dst, b, h) do { _Pragma("unroll") for (int n = 0; n < 2; ++n) _Pragma("unroll") for (int k = 0; k < 2; ++k) dst[n][k] = *(const LAS bf16x8*)(lds + PG8_SB(b, h) + boff + n * 2048 + k * 1024); } while (0)
#define PG8_MMA(ai, bj, At, Bt) do { __builtin_amdgcn_s_setprio(1); _Pragma("unroll") for (int m = 0; m < 4; ++m) _Pragma("unroll") for (int n = 0; n < 2; ++n) _Pragma("unroll") for (int k = 0; k < 2; ++k) \
        acc[ai][bj][m][n] = __builtin_amdgcn_mfma_f32_16x16x32_bf16(Bt[n][k], At[m][k], acc[ai][bj][m][n], 0, 0, 0); __builtin_amdgcn_s_setprio(0); } while (0)
#define PG8_WAIT_V(n) asm volatile("s_waitcnt vmcnt(" #n ")" ::: "memory")
#define PG8_WAIT_L(n) asm volatile("s_waitcnt lgkmcnt(" #n ")" ::: "memory")
#define PG8_BAR __builtin_amdgcn_s_barrier()
#define PG8_SCHED __builtin_amdgcn_sched_barrier(0)
    Unit cur, nxt; int ui = 0;
    if (!S.next(0, cur)) return;
    f32x4 acc[2][2][4][2];
#pragma unroll
    for (int a = 0; a < 2; ++a)
#pragma unroll
        for (int b = 0; b < 2; ++b)
#pragma unroll
            for (int m = 0; m < 4; ++m)
#pragma unroll
                for (int n = 0; n < 2; ++n) acc[a][b][m][n] = (f32x4){0.f, 0.f, 0.f, 0.f};
    bf16x8 At[4][2], B0[2][2], B1[2][2];
    const char* cA = (const char*)g.A + (size_t)cur.pm * tstepA + (size_t)cur.pn * pnoffA + (size_t)cur.ks * ksoff; const char* cB = (const char*)g.Bt + (size_t)cur.pn * tstepB + (size_t)cur.ks * ksoff;
    PG8_STAGE(PG8_SB(0, 0), cB, voffB); PG8_STAGE(PG8_SB(0, 1), cB + hstepB, voffB); PG8_STAGE(PG8_SA(0, 0), cA, voffA); PG8_STAGE(PG8_SA(0, 1), cA + hstepA, voffA);
    if (wr == 1) PG8_BAR;
    PG8_WAIT_V(2); PG8_BAR;
    PG8_STAGE(PG8_SB(1, 0), cB + kstep, voffB); PG8_STAGE(PG8_SA(1, 0), cA + kstep, voffA); PG8_STAGE(PG8_SB(1, 1), cB + hstepB + kstep, voffB);
    PG8_WAIT_V(6); PG8_BAR;
    for (;;) {
        const bool has_next = S.next(ui + 1, nxt);
        const char* nA = has_next ? (const char*)g.A + (size_t)nxt.pm * tstepA + (size_t)nxt.pn * pnoffA + (size_t)nxt.ks * ksoff : cA; const char* nB = has_next ? (const char*)g.Bt + (size_t)nxt.pn * tstepB + (size_t)nxt.ks * ksoff : cB;
        for (int t = 0; t < nt; t += 2) {
            const bool last = (t == nt - 2);
            const char* a1 = cA + (size_t)(t + 1) * kstep;
            const char* a2 = last ? nA : cA + (size_t)(t + 2) * kstep; const char* b2 = last ? nB : cB + (size_t)(t + 2) * kstep;
            const char* a3 = a2 + kstep; const char* b3 = b2 + kstep;
            PG8_LDB(B0, 0, 0); PG8_LDB(B1, 0, 1); PG8_SCHED; PG8_LDA(At, 0, 0); PG8_STAGE(PG8_SA(1, 1), a1 + hstepA, voffA);
            PG8_WAIT_V(8); PG8_WAIT_L(0); PG8_BAR; PG8_MMA(0, 0, At, B0); PG8_MMA(0, 1, At, B1); PG8_BAR; PG8_SCHED;
            PG8_LDA(At, 0, 1); PG8_STAGE(PG8_SB(0, 0), b2, voffB); PG8_STAGE(PG8_SB(0, 1), b2 + hstepB, voffB); PG8_STAGE(PG8_SA(0, 0), a2, voffA);
            PG8_WAIT_V(8); PG8_WAIT_L(0); PG8_BAR; PG8_MMA(1, 0, At, B0); PG8_MMA(1, 1, At, B1); PG8_BAR; PG8_SCHED;
            PG8_LDB(B0, 1, 0); PG8_LDB(B1, 1, 1); PG8_SCHED; PG8_LDA(At, 1, 0); PG8_STAGE(PG8_SA(0, 1), a2 + hstepA, voffA);
            PG8_WAIT_V(8); PG8_WAIT_L(0); PG8_BAR; PG8_MMA(0, 0, At, B0); PG8_MMA(0, 1, At, B1); PG8_BAR; PG8_SCHED;
            PG8_LDA(At, 1, 1); PG8_STAGE(PG8_SB(1, 0), b3, voffB); PG8_STAGE(PG8_SB(1, 1), b3 + hstepB, voffB); PG8_STAGE(PG8_SA(1, 0), a3, voffA);
            PG8_WAIT_V(8); PG8_WAIT_L(0); PG8_BAR; PG8_MMA(1, 0, At, B0); PG8_MMA(1, 1, At, B1); PG8_BAR; PG8_SCHED;
        }
        if constexpr (ALIGN_EPI) { if (wr == 0) PG8_BAR; }
        E(acc, cur, wr, wc, fr, fq, xlds);
        if (!has_next) break;
#pragma unroll
        for (int a = 0; a < 2; ++a)
#pragma unroll
            for (int b = 0; b < 2; ++b)
#pragma unroll
                for (int m = 0; m < 4; ++m)
#pragma unroll
                    for (int n = 0; n < 2; ++n) acc[a][b][m][n] = (f32x4){0.f, 0.f, 0.f, 0.f};
        cur = nxt; cA = nA; cB = nB; ++ui;
        if constexpr (ALIGN_EPI) { if (wr == 1) PG8_BAR; }
    }
    PG8_WAIT_V(0);
    if constexpr (!ALIGN_EPI) { if (wr == 0) PG8_BAR; }
    PG8_BAR;
#undef PG8_SA
#undef PG8_SB
#undef PG8_STAGE
#undef PG8_LDA
#undef PG8_LDB
#undef PG8_MMA
#undef PG8_WAIT_V
#undef PG8_WAIT_L
#undef PG8_BAR
#undef PG8_SCHED
}
}

#define XB_TMO      128
#define XB_XCNT(j)  (256  + 64 * (j))
#define XB_XSUB(j)  (1280 + 64 * (j))
#define XB_XGEN(j)  (2304 + 64 * (j))
#define XB_TOP      3328
#define XB_TOPGEN   3392
#define XCD_BAR_WORDS 3456
#define XB_SPIN_CAP (1u << 22)
__device__ __forceinline__ unsigned xb_ld(unsigned* p)              { return __hip_atomic_load(p, __ATOMIC_RELAXED, __HIP_MEMORY_SCOPE_AGENT); }
__device__ __forceinline__ unsigned xb_add(unsigned* p, unsigned v) { return __hip_atomic_fetch_add(p, v, __ATOMIC_RELAXED, __HIP_MEMORY_SCOPE_AGENT); }
__device__ __forceinline__ unsigned xb_xcc_id() { return (unsigned)__builtin_amdgcn_s_getreg((3 << 11) | 20) & 0xFu; }
#define XB_SPIN(cond, bar) do { unsigned _sp = 0; while (cond) { __builtin_amdgcn_s_sleep(1); \
    if ((++_sp & 255u) == 0u) { if (xb_ld(&(bar)[XB_TMO])) break; if (_sp > XB_SPIN_CAP) { atomicAdd(&(bar)[XB_TMO], 1u); break; } } } } while (0)
struct XcdBarrier { unsigned* bar; unsigned x; volatile LAS unsigned* st; };
__device__ __forceinline__ XcdBarrier xcd_barrier_post(unsigned* bar, volatile LAS unsigned* st) {
    XcdBarrier b; b.bar = bar; b.x = xb_xcc_id(); b.st = st;
    if (threadIdx.x == 0) (void)xb_add(&bar[XB_XCNT(b.x)], 1u);
    return b;
}
__device__ __forceinline__ void xcd_barrier_complete(unsigned* bar, unsigned x, unsigned& nloc, unsigned& nx) {
    const unsigned G = gridDim.x * gridDim.y * gridDim.z;
    unsigned sum, cnt, mine, sp = 0u;
    for (;;) {
        sum = 0u; cnt = 0u; mine = 0u;
#pragma unroll
        for (unsigned j = 0; j < 16; ++j) { const unsigned c = xb_ld(&bar[XB_XCNT(j)]); sum += c; cnt += (c > 0u) ? 1u : 0u; }
        mine = xb_ld(&bar[XB_XCNT(x)]);
        if (sum == G) break;
        __builtin_amdgcn_s_sleep(1);
        if ((++sp & 255u) == 0u) { if (xb_ld(&bar[XB_TMO])) break; if (sp > XB_SPIN_CAP) { atomicAdd(&bar[XB_TMO], 1u); break; } }
    }
    nloc = mine > 0u ? mine : 1u; nx = cnt > 0u ? cnt : 1u;
}
__device__ __forceinline__ void xcd_barrier_kp(kp_t kp, volatile LAS unsigned* st) {
    XcdBarrier b; b.st = st;
    asm volatile("s_waitcnt vmcnt(0)" ::: "memory");
    __syncthreads();
    if (threadIdx.x == 0) {
        KP_LAUNDER();
        unsigned* bar = (unsigned*)(KWS() + WS_CTL) + CW_BAR; unsigned bx_ = xb_xcc_id();
        asm volatile("" : "+s"(bar), "+s"(bx_));
        __builtin_amdgcn_s_waitcnt(0);
        unsigned nloc = b.st[0], nx = b.st[1];
        if (nloc == 0u) { xcd_barrier_complete(bar, bx_, nloc, nx); b.st[0] = nloc; b.st[1] = nx; }
        const unsigned old = xb_add(&bar[XB_XSUB(bx_)], 1u);
        const unsigned gen = old / nloc;
        if (old + 1u == (gen + 1u) * nloc) {
            __builtin_amdgcn_fence(__ATOMIC_RELEASE, "agent");
            asm volatile("s_waitcnt vmcnt(0)" ::: "memory");
            const unsigned og = xb_add(&bar[XB_TOP], 1u);
            const unsigned tg = og / nx;
            if (og + 1u == (tg + 1u) * nx) xb_add(&bar[XB_TOPGEN], 1u);
            else XB_SPIN(xb_ld(&bar[XB_TOPGEN]) == tg, bar);
            __builtin_amdgcn_fence(__ATOMIC_ACQUIRE, "agent");
            xb_add(&bar[XB_XGEN(bx_)], 1u);
            asm volatile("s_waitcnt vmcnt(0)" ::: "memory");
        } else {
            XB_SPIN(xb_ld(&bar[XB_XGEN(bx_)]) == gen, bar);
            __builtin_amdgcn_fence(__ATOMIC_ACQUIRE, "agent");
            asm volatile("s_waitcnt vmcnt(0)" ::: "memory");
        }
    }
    __syncthreads();
}

struct Args { const float* in[30]; float* out; unsigned char* ws; };

__device__ __forceinline__ void transpose_item(const float* W, int ldw, int k0, int n0, bf16_t* WT, int ldt, int drow0, LAS float* scr, int lane) {
    float tv[32];
#pragma unroll
    for (int i = 0; i < 32; ++i) { const int kk = 2 * i + (lane >> 5); tv[i] = __builtin_nontemporal_load(&W[(size_t)(k0 + kk) * ldw + n0 + (lane & 31)]); }
#pragma unroll
    for (int i = 0; i < 32; ++i) { const int kk = 2 * i + (lane >> 5); scr[kk * 33 + (lane & 31)] = tv[i]; }
    asm volatile("s_waitcnt lgkmcnt(0)" ::: "memory");
    const int c = lane & 7;
#pragma unroll
    for (int j = 0; j < 4; ++j) { const int n = (lane >> 3) + 8 * j; const LAS float* s = scr + (8 * c) * 33 + n;
        u32x4 o; o.x = cvt_pk_bf16(s[0 * 33], s[1 * 33]); o.y = cvt_pk_bf16(s[2 * 33], s[3 * 33]); o.z = cvt_pk_bf16(s[4 * 33], s[5 * 33]); o.w = cvt_pk_bf16(s[6 * 33], s[7 * 33]);
        *(u32x4*)(WT + (size_t)(drow0 + n) * ldt + k0 + 8 * c) = o; }
    asm volatile("s_waitcnt lgkmcnt(0)" ::: "memory");
}
__device__ __forceinline__ void sincos_d(double x, double& s, double& c) {
    const double k = rint(x * 0.63661977236758134308);
    double r = fma(-k, 1.57079632679489655800e+00, x); r = fma(-k, 6.12323399573676603587e-17, r);
    const double r2 = r * r;
    double sp = -7.6471637318198164759e-13; sp = fma(sp, r2, 1.6059043836821614599e-10); sp = fma(sp, r2, -2.5052108385441718775e-08); sp = fma(sp, r2, 2.7557319223985890653e-06);
    sp = fma(sp, r2, -1.9841269841269841270e-04); sp = fma(sp, r2, 8.3333333333333333333e-03); sp = fma(sp, r2, -1.6666666666666666667e-01);
    const double sr = fma(sp * r2, r, r);
    double cp = 4.7794773323873852974e-14; cp = fma(cp, r2, -1.1470745597729724714e-11); cp = fma(cp, r2, 2.0876756987868098979e-09); cp = fma(cp, r2, -2.7557319223985890653e-07);
    cp = fma(cp, r2, 2.4801587301587301587e-05); cp = fma(cp, r2, -1.3888888888888888889e-03); cp = fma(cp, r2, 4.1666666666666666667e-02); cp = fma(cp, r2, -0.5);
    const double cr = fma(cp, r2, 1.0);
    const int q = ((int)k) & 3;
    s = (q == 0) ? sr : (q == 1) ? cr : (q == 2) ? -sr : -cr;
    c = (q == 0) ? cr : (q == 1) ? -sr : (q == 2) ? -cr : sr;
}

template <int W, bool SAMPLE>
__device__ __forceinline__ void pool_item(int it, int c4, const float* xp, const float* xs, const float* spool, const float* rstd0, const float* mod0, const float* g0,
                                          bf16_t* pooled, float* o_poolp, float* o_pools) {
    const f32x4 gv = *(const f32x4*)(g0 + c4);
    constexpr float invW = 1.0f / W;
    if constexpr (!SAMPLE) {
        const int r0 = it * 32, b = r0 >> 11, t0 = r0 & (SEQ - 1);
        const f32x4 shv = *(const f32x4*)(mod0 + (size_t)b * 6144 + c4), scv = *(const f32x4*)(mod0 + (size_t)b * 6144 + 1024 + c4);
        const f32x4 gs = gv * (scv + 1.0f);
        f32x4 ring[W];
#pragma unroll
        for (int i = 0; i < W - 1; ++i) {
            const int t = t0 - (W - 1) + i; const int row = t >= 0 ? r0 - (W - 1) + i : r0;
            ring[i] = *(const f32x4*)(xp + (size_t)row * D + c4);
        }
        asm volatile("" ::: "memory");
#pragma unroll
        for (int i = 0; i < W - 1; ++i) {
            const int t = t0 - (W - 1) + i; const int row = t >= 0 ? r0 - (W - 1) + i : r0;
            const float keep = t >= 0 ? 1.0f : 0.0f;
            ring[i] = (ring[i] * rstd0[row] * gs + shv) * keep;
        }
        ring[W - 1] = (f32x4){0.f, 0.f, 0.f, 0.f};
        f32x4 rs = ring[0];
#pragma unroll
        for (int k = 1; k < W - 1; ++k) rs += ring[k];
        constexpr int QB = (W >= 16) ? 8 : 16;
#pragma unroll
        for (int q8 = 0; q8 < 32; q8 += QB) {
            f32x4 xv[QB];
#pragma unroll
            for (int i = 0; i < QB; ++i) xv[i] = *(const f32x4*)(xp + (size_t)(r0 + q8 + i) * D + c4);
            asm volatile("" ::: "memory");
#pragma unroll
            for (int i = 0; i < QB; ++i) {
                const int q = q8 + i, row = r0 + q, t = t0 + q;
                const f32x4 h = xv[i] * rstd0[row] * gs + shv;
                f32x4 s;
                if constexpr (W >= 8) { rs = rs - ring[(q + W - 1) % W] + h; ring[(q + W - 1) % W] = h; s = rs; }
                else {
                    ring[(q + W - 1) % W] = h;
                    s = ring[0];
#pragma unroll
                    for (int k = 1; k < W; ++k) s += ring[k];
                }
                const float ic = (t + 1 >= W) ? invW : 1.0f / (float)(t + 1);
                const f32x4 o = s * ic - h;
                u32x2 w; w.x = cvt_pk_bf16(o[0], o[1]); w.y = cvt_pk_bf16(o[2], o[3]);
                *(u32x2*)(pooled + (size_t)row * D + c4) = w;
                if (t >= SEQ - 15) stnt4(o_poolp + ((size_t)b * 15 + (t - (SEQ - 15))) * D + c4, h);
            }
            asm volatile("" ::: "memory");
        }
    } else {
        {
            const int b = it, cb = 8 + b;
            const f32x4 shv = *(const f32x4*)(mod0 + (size_t)cb * 6144 + c4), scv = *(const f32x4*)(mod0 + (size_t)cb * 6144 + 1024 + c4);
            const f32x4 gs = gv * (scv + 1.0f);
            const float* sp = spool + (size_t)b * 15 * D + c4;
            f32x4 ring[W];
#pragma unroll
            for (int i = 0; i < W - 1; ++i) ring[i] = *(const f32x4*)(sp + (size_t)(15 - (W - 1) + i) * D);
            asm volatile("" ::: "memory");
#pragma unroll
            for (int i = 0; i < 7; ++i) *(f32x4*)(o_pools + ((size_t)b * 15 + i) * D + c4) = *(const f32x4*)(sp + (size_t)(8 + i) * D);
            asm volatile("" ::: "memory");
#pragma unroll
            for (int q = 0; q < 8; ++q) {
                const int row = NPR + b * 8 + q;
                const f32x4 h = *(const f32x4*)(xs + (size_t)(b * 8 + q) * D + c4) * rstd0[row] * gs + shv;
                ring[(q + W - 1) % W] = h;
                f32x4 s = ring[0];
#pragma unroll
                for (int i = 1; i < W; ++i) s += ring[i];
                const f32x4 o = s * invW - h;
                u32x2 w; w.x = cvt_pk_bf16(o[0], o[1]); w.y = cvt_pk_bf16(o[2], o[3]);
                *(u32x2*)(pooled + (size_t)row * D + c4) = w;
                stnt4(o_pools + ((size_t)b * 15 + 7 + q) * D + c4, h);
            }
        }
    }
}

__device__ __forceinline__ f32x4 bf4(u32x2 w) { return (f32x4){__builtin_bit_cast(float, w.x << 16), __builtin_bit_cast(float, w.x & 0xffff0000u), __builtin_bit_cast(float, w.y << 16), __builtin_bit_cast(float, w.y & 0xffff0000u)}; }
template <int PM, bool YIN_F32, bool YOUT_F32>
__device__ __forceinline__ void row_phase(int gw, int NGW, int lane, const float* yin_p, const float* yin_s, float* yout, bf16_t* yb, const bf16_t* mb, const bf16_t* part,
                                          const float* modl, int gate_off, const float* post_g,
                                          const float* nmod, int nsh_off, int nsc_off, const float* ng, bf16_t* aout) {
    constexpr int RQ = 4;
    for (int row0 = gw; row0 < MROWS; row0 += RQ * NGW) {
        f32x4 y[RQ][4], m[RQ][4]; int rows[RQ]; bool ok[RQ];
#pragma unroll
        for (int q = 0; q < RQ; ++q) {
            const int row = row0 + q * NGW; rows[q] = row; ok[q] = row < MROWS;
            if (!ok[q]) continue;
            if constexpr (YIN_F32) {
                const float* yr = row < NPR ? yin_p + (size_t)row * D : yin_s + (size_t)(row - NPR) * D;
#pragma unroll
                for (int j = 0; j < 4; ++j) y[q][j] = ldnt4(yr + 4 * lane + 256 * j);
            } else {
#pragma unroll
                for (int j = 0; j < 4; ++j) y[q][j] = bf4(ldnt2u(yb + (size_t)row * D + 4 * lane + 256 * j));
            }
            if (PM == 1 && row >= NPR) {
#pragma unroll
                for (int j = 0; j < 4; ++j) m[q][j] = (f32x4){0.f, 0.f, 0.f, 0.f};
#pragma unroll 1
                for (int ks = 0; ks < NKS; ++ks) {
                    const bf16_t* pr = part + ((size_t)ks * NSR + (row - NPR)) * D;
#pragma unroll
                    for (int j = 0; j < 4; ++j) m[q][j] += bf4(ldnt2u(pr + 4 * lane + 256 * j));
                }
            } else if (PM == 2 && row >= NPR) {
#pragma unroll
                for (int j = 0; j < 4; ++j) {
                    const int c = 4 * lane + 256 * j, pc = 256 * (c >> 7) + (c & 127);
                    f32x4 av = (f32x4){0.f, 0.f, 0.f, 0.f}, bv = av;
#pragma unroll
                    for (int ks = 0; ks < NKG; ++ks) { const bf16_t* pr = part + ((size_t)ks * NSR + (row - NPR)) * 2 * D + pc; av += bf4(*(const u32x2*)pr); bv += bf4(*(const u32x2*)(pr + 128)); }
                    m[q][j] = (f32x4){av[0] * sigmoidf_(bv[0]), av[1] * sigmoidf_(bv[1]), av[2] * sigmoidf_(bv[2]), av[3] * sigmoidf_(bv[3])};
                }
            } else {
                const bf16_t* mr = mb + (size_t)row * D;
#pragma unroll
                for (int j = 0; j < 4; ++j) m[q][j] = bf4(ldnt2u(mr + 4 * lane + 256 * j));
            }
        }
#pragma unroll
        for (int q = 0; q < RQ; ++q) {
            if (!ok[q]) continue;
            const int row = rows[q];
            const int cb = row < NPR ? (row >> 11) : 8 + ((row - NPR) >> 3);
            float ss = 0.f;
#pragma unroll
            for (int j = 0; j < 4; ++j) ss += (m[q][j][0] * m[q][j][0] + m[q][j][1] * m[q][j][1]) + (m[q][j][2] * m[q][j][2] + m[q][j][3] * m[q][j][3]);
            const float rm = 1.0f / sqrtf(wave_sum(ss) * (1.0f / D) + EPS);
            float s2 = 0.f;
#pragma unroll
            for (int j = 0; j < 4; ++j) { const int c = 4 * lane + 256 * j;
                const f32x4 gt = *(const f32x4*)(modl + (size_t)cb * 6144 + gate_off + c), pg = *(const f32x4*)(post_g + c);
                y[q][j] = y[q][j] + gt * (m[q][j] * rm * pg);
                if constexpr (YOUT_F32) stnt4(yout + (size_t)row * D + c, y[q][j]);
                else { u32x2 wy; wy.x = cvt_pk_bf16(y[q][j][0], y[q][j][1]); wy.y = cvt_pk_bf16(y[q][j][2], y[q][j][3]); *(u32x2*)(yb + (size_t)row * D + c) = wy; }
                s2 += (y[q][j][0] * y[q][j][0] + y[q][j][1] * y[q][j][1]) + (y[q][j][2] * y[q][j][2] + y[q][j][3] * y[q][j][3]); }
            if (aout) {
                const float ry = 1.0f / sqrtf(wave_sum(s2) * (1.0f / D) + EPS);
#pragma unroll
                for (int j = 0; j < 4; ++j) { const int c = 4 * lane + 256 * j;
                    const f32x4 g = *(const f32x4*)(ng + c), sc = *(const f32x4*)(nmod + (size_t)cb * 6144 + nsc_off + c), sh = *(const f32x4*)(nmod + (size_t)cb * 6144 + nsh_off + c);
                    const f32x4 f = y[q][j] * ry * g * (sc + 1.0f) + sh;
                    u32x2 w; w.x = cvt_pk_bf16(f[0], f[1]); w.y = cvt_pk_bf16(f[2], f[3]);
                    *(u32x2*)(aout + (size_t)row * D + c) = w; }
            }
        }
    }
}

constexpr int S5_SEG = 512, S5_NSEG = SEQ / S5_SEG;
constexpr int S5_LP = 68;
template <int MODE>
__device__ __forceinline__ void s5_unit(int unit, int lane, LAS float* T, const bf16_t* H, bf16_t* GY, const bf16_t* BBT, const bf16_t* CMT, const float* LBR, const float* LBI,
                                        const float* x0re, const float* x0im, float* ore, float* oim, float* carry) {
    constexpr bool SAMPLE = (MODE == 1);
    int g, row0, ntiles, b0, seg = 0;
    if constexpr (MODE == 0) { seg = unit & 3; g = (unit >> 2) & 63; b0 = unit >> 8; row0 = b0 * SEQ + seg * S5_SEG; ntiles = S5_SEG / 32; }
    else if constexpr (MODE == 2) { seg = unit % 3; const int bg = unit / 3; g = bg & 63; b0 = bg >> 6; row0 = b0 * SEQ + seg * S5_SEG; ntiles = S5_SEG / 32; }
    else { g = unit & 63; const int ch = unit >> 6; row0 = NPR + ch * 32; ntiles = 1; b0 = ch * 4; }
    const int p = lane;
    LAS unsigned* TP = (LAS unsigned*)T;
    const float lbr = LBR[g * 64 + p], lbi = LBI[g * 64 + p];
    bf16x8 bb[4], cm[5];
#pragma unroll
    for (int nt = 0; nt < 4; ++nt) bb[nt] = *(const bf16x8*)(BBT + ((size_t)(g * 128 + 32 * nt + (lane & 31)) * 16 + 8 * (lane >> 5)));
    if constexpr (MODE != 2) {
#pragma unroll
        for (int ks = 0; ks < 5; ++ks) cm[ks] = *(const bf16x8*)(CMT + ((size_t)(g * 16 + (lane & 15)) * 160 + 32 * ks + 8 * (lane >> 4)));
    }
    float sr = 0.f, si = 0.f;
    if constexpr (MODE == 0) {
        if (seg > 0) {
            float pr = lbr, pi = lbi;
#pragma unroll
            for (int i = 0; i < 9; ++i) { const float nr = pr * pr - pi * pi, ni = 2.f * pr * pi; pr = nr; pi = ni; }
            const float* cp = carry + ((size_t)(b0 * 64 + g) * 3) * 128 + p;
            for (int j = 0; j < seg; ++j) { const float er = cp[j * 128], ei = cp[j * 128 + 64]; const float nr = pr * sr - pi * si + er, ni = pr * si + pi * sr + ei; sr = nr; si = ni; }
        }
    }
    float x0r[4] = {0.f, 0.f, 0.f, 0.f}, x0i[4] = {0.f, 0.f, 0.f, 0.f};
    if constexpr (SAMPLE) {
#pragma unroll
        for (int k = 0; k < 4; ++k) { const size_t xi = ((size_t)(b0 + k) * 64 + g) * 64 + p; x0r[k] = x0re[xi]; x0i[k] = x0im[xi]; }
    }
    const bf16x8 zero8 = (bf16x8){0, 0, 0, 0, 0, 0, 0, 0};
    const bf16_t* hb = H + (size_t)row0 * D + g * 16;
    bf16x8 ua = *(const bf16x8*)(hb + (size_t)(lane & 31) * D + 8 * (lane >> 5));
    bf16x8 ud0 = zero8, ud1 = zero8;
    if constexpr (MODE != 2) { if (lane < 32) { ud0 = *(const bf16x8*)(hb + (size_t)(lane & 15) * D + 8 * (lane >> 4)); ud1 = *(const bf16x8*)(hb + (size_t)(16 + (lane & 15)) * D + 8 * (lane >> 4)); } }
#pragma unroll 2
    for (int tile = 0; tile < ntiles; ++tile) {
        const bf16x8 ca = ua, cd0 = ud0, cd1 = ud1;
        if (tile + 1 < ntiles) {
            const bf16_t* hn = hb + (size_t)(tile + 1) * 32 * D;
            ua = *(const bf16x8*)(hn + (size_t)(lane & 31) * D + 8 * (lane >> 5));
            if constexpr (MODE != 2) { if (lane < 32) { ud0 = *(const bf16x8*)(hn + (size_t)(lane & 15) * D + 8 * (lane >> 4)); ud1 = *(const bf16x8*)(hn + (size_t)(16 + (lane & 15)) * D + 8 * (lane >> 4)); } }
        }
        f32x16 z0, z1, z2, z3;
#pragma unroll
        for (int i = 0; i < 16; ++i) { z0[i] = 0.f; z1[i] = 0.f; z2[i] = 0.f; z3[i] = 0.f; }
        z0 = __builtin_amdgcn_mfma_f32_32x32x16_bf16(ca, bb[0], z0, 0, 0, 0);
        z1 = __builtin_amdgcn_mfma_f32_32x32x16_bf16(ca, bb[1], z1, 0, 0, 0);
        z2 = __builtin_amdgcn_mfma_f32_32x32x16_bf16(ca, bb[2], z2, 0, 0, 0);
        z3 = __builtin_amdgcn_mfma_f32_32x32x16_bf16(ca, bb[3], z3, 0, 0, 0);
        asm volatile("s_nop 15\n\ts_nop 15\n\ts_nop 15\n\ts_nop 15\n\ts_nop 15" : "+v"(z0), "+v"(z1), "+v"(z2), "+v"(z3));
#pragma unroll
        for (int r = 0; r < 16; ++r) {
            float x0 = z0[r], x1 = z1[r], x2 = z2[r], x3 = z3[r];
            asm volatile("s_nop 1\n\tv_permlane32_swap_b32 %0, %1" : "+v"(x0), "+v"(x1));
            asm volatile("s_nop 1\n\tv_permlane32_swap_b32 %0, %1" : "+v"(x2), "+v"(x3));
            z0[r] = x0; z1[r] = x1; z2[r] = x2; z3[r] = x3;
        }
#pragma unroll
        for (int j = 0; j < 4; ++j) {
#pragma unroll
            for (int hh = 0; hh < 2; ++hh)
#pragma unroll
                for (int i = 0; i < 4; ++i) {
                    const int r = 4 * j + i, t = 8 * j + 4 * hh + i;
                    if constexpr (SAMPLE) { if ((t & 7) == 0) { sr = x0r[t >> 3]; si = x0i[t >> 3]; } }
                    const float br = hh ? z1[r] : z0[r], bi = hh ? z3[r] : z2[r];
                    const float nr = __builtin_fmaf(lbr, sr, __builtin_fmaf(-lbi, si, br)), ni = __builtin_fmaf(lbr, si, __builtin_fmaf(lbi, sr, bi));
                    sr = nr; si = ni;
                    if (hh) { z1[r] = nr; z3[r] = ni; } else { z0[r] = nr; z2[r] = ni; }
                    if constexpr (SAMPLE) { if ((t & 7) == 7) { const size_t xi = ((size_t)(b0 + (t >> 3)) * 64 + g) * 64 + p; ore[xi] = sr; oim[xi] = si; } }
                }
        }
        if constexpr (MODE != 2) {
#pragma unroll
            for (int r = 0; r < 16; ++r) {
                const int t0 = (r & 3) + 8 * (r >> 2);
                TP[t0 * S5_LP + p] = cvt_pk_bf16(z0[r], z2[r]);
                TP[(t0 + 4) * S5_LP + p] = cvt_pk_bf16(z1[r], z3[r]);
            }
        }
        asm volatile("s_waitcnt lgkmcnt(0)" ::: "memory");
        if constexpr (MODE != 2) {
#pragma unroll
        for (int rt = 0; rt < 2; ++rt) {
            f32x4 y = (f32x4){0.f, 0.f, 0.f, 0.f};
#pragma unroll
            for (int ks = 0; ks < 4; ++ks) {
                const u32x4 pk = *(const LAS u32x4*)(TP + (16 * rt + (lane & 15)) * S5_LP + 16 * ks + 4 * (lane >> 4));
                y = __builtin_amdgcn_mfma_f32_16x16x32_bf16(__builtin_bit_cast(bf16x8, pk), cm[ks], y, 0, 0, 0);
            }
            y = __builtin_amdgcn_mfma_f32_16x16x32_bf16(rt ? cd1 : cd0, cm[4], y, 0, 0, 0);
            const f32x2 ga = gelu_pk((f32x2){y[0], y[1]}), gb = gelu_pk((f32x2){y[2], y[3]});
            const unsigned pa = cvt_pk_bf16(ga.x, ga.y), pb = cvt_pk_bf16(gb.x, gb.y);
            {
                const size_t o0 = (size_t)(row0 + tile * 32 + 16 * rt + 4 * (lane >> 4)) * D + g * 16 + (lane & 15);
                GY[o0] = (bf16_t)(pa & 0xffffu); GY[o0 + D] = (bf16_t)(pa >> 16); GY[o0 + 2 * D] = (bf16_t)(pb & 0xffffu); GY[o0 + 3 * D] = (bf16_t)(pb >> 16);
            }
        }
        asm volatile("s_waitcnt lgkmcnt(0)" ::: "memory");
        }
    }
    if constexpr (MODE == 0) { if (seg == S5_NSEG - 1) { const size_t xi = ((size_t)b0 * 64 + g) * 64 + p; ore[xi] = sr; oim[xi] = si; } }
    if constexpr (MODE == 2) { float* cp = carry + ((size_t)(b0 * 64 + g) * 3 + seg) * 128 + p; cp[0] = sr; cp[64] = si; }
}

#define PH_SC() int G = gridDim.x, bx = blockIdx.x; asm volatile("" : "+s"(G), "+s"(bx)); (void)G; (void)bx
#define PH_IDS() PH_SC(); int tid = wave0 * 64 + hw_lane(); asm volatile("" : "+v"(tid)); const int vcu = (G % 8 == 0) ? (bx % 8) * (G / 8) + bx / 8 : bx; const int NGW = G * 8; const int lane = tid & 63, wave = __builtin_amdgcn_readfirstlane(tid >> 6), gw = vcu * 8 + wave; (void)lane; (void)gw; (void)NGW
#ifndef REP_BAR
#define REP_BAR 1
#endif
#define GRID_BAR() do { for (int rb_ = 0; rb_ < REP_BAR; ++rb_) xcd_barrier_kp(kp, (volatile LAS unsigned*)(lds + MISC_OFF) + 8); } while (0)

template <int l>
__device__ __forceinline__ void rowa_phase(kp_t kp, LAS unsigned char* lds, const int wave0) {
        {
            PH_IDS();
            float* Y = KOUT() + O_Y; const float* modl = WSP(float, WS_MOD) + (size_t)l * NCB * 6144;
            row_phase<(l == 0 ? 0 : 2), (l == 0), false>(gw, NGW, lane, KIN(I_XP), KIN(I_XS), Y, WSP(bf16_t, WS_YB), WSP(bf16_t, WS_MBUF), WSP(bf16_t, WS_PARTG), modl, 2048, KIN(I_MPOSTG) + l * D,
                      modl, 3072, 4096, KIN(I_FPREG) + l * D, WSP(bf16_t, WS_ABUF));
        }
}

template <int l>
__device__ __forceinline__ void down_phase(kp_t kp, LAS unsigned char* lds, const int wave0) {
        {
            PH_IDS();
            const float* cw = KIN(I_CONVW) + (size_t)l * 3 * FU; const float* cbv = KIN(I_CONVB) + (size_t)l * FU;
            const float* BND = WSP(float, WS_BND); bf16_t* ACT = WSP(bf16_t, WS_ACT);
            pg8::StaticOrder S0; S0.init(NPR, D, G, bx); pg8::Unit u0;
            if (S0.next(0, u0) && (u0.pm & 7) != 0) {
                const int pm = u0.pm;
                for (int j = tid; j < FH; j += 512) {
                    float e[2][4];
#pragma unroll
                    for (int h = 0; h < 2; ++h) { const int oc = h * FH + j;
                        e[h][0] = BND[((size_t)(pm - 1) * 4 + 2) * FU + oc]; e[h][1] = BND[((size_t)(pm - 1) * 4 + 3) * FU + oc];
                        e[h][2] = BND[((size_t)pm * 4 + 0) * FU + oc]; e[h][3] = BND[((size_t)pm * 4 + 1) * FU + oc]; }
#pragma unroll
                    for (int r = 0; r < 2; ++r) {
                        float cv[2];
#pragma unroll
                        for (int h = 0; h < 2; ++h) { const int oc = h * FH + j; cv[h] = cbv[oc] + cw[oc] * e[h][r] + cw[FU + oc] * e[h][r + 1] + cw[2 * FU + oc] * e[h][r + 2]; }
                        ACT[(size_t)(pm * 256 + r) * FH + j] = (bf16_t)(cvt_pk_bf16(gelu1(cv[0]) * cv[1], 0.f) & 0xffffu);
                    }
                }
            }
            float* ocp = KOUT() + O_CONVP + (size_t)l * 8 * 2 * FU;
            for (int i = bx * 512 + tid; i < 8 * 2 * FU; i += G * 512) {
                const int b = i / (2 * FU), sidx = (i / FU) & 1, n = i % FU;
                ocp[i] = BND[((size_t)(8 * b + 7) * 4 + 2 + sidx) * FU + n];
            }
            asm volatile("s_waitcnt vmcnt(0)" ::: "memory");
            __syncthreads();
        }
        KP_LAUNDER();
        {
            PH_SC();
            pg8::Gemm g{WSP(bf16_t, WS_ACT), WSP(bf16_t, WS_WDN) + (size_t)l * D * FH, FH, FH, FH, 0, 0}; pg8::StaticOrder S; S.init(NPR, D, G, bx);
            pg8::EpiBf16 E{kp, 1};
            pg8::gemm_phase<pg8::EpiBf16, true, pg8::StaticOrder>(lds, lds + XCH_OFF, g, S, E, wave0);
        }
        KP_LAUNDER();
        {
            PH_SC();
            pg8::Gemm g{WSP(bf16_t, WS_ACT), WSP(bf16_t, WS_WDN) + (size_t)l * D * FH, 256, FH, FH, 0, 256}; pg8::SliceOrder<11, 4> S{bx};
            pg8::EpiBf16 E{kp, 2};
            pg8::gemm_phase<pg8::EpiBf16, true, pg8::SliceOrder<11, 4>>(lds, lds + XCH_OFF, g, S, E, wave0);
        }
}

template <int l>
__device__ __forceinline__ void ffn_block(kp_t kp, LAS unsigned char* lds, const int wave0) {
        KP_LAUNDER();
        rowa_phase<l>(kp, lds, wave0);
#if defined(REP_ROWA0)
        if (l == 0) { GRID_BAR(); KP_LAUNDER(); rowa_phase<l>(kp, lds, wave0); }
#endif
        GRID_BAR();
        KP_LAUNDER();
#ifndef REP_UP
#define REP_UP 1
#endif
#pragma unroll 1
        for (int rep = 0; rep < REP_UP; ++rep) {
            if (rep) { GRID_BAR(); KP_LAUNDER(); }
            PH_SC();
            pg8::Gemm g{WSP(bf16_t, WS_ABUF), WSP(bf16_t, WS_WUP) + (size_t)l * FU * D, D, D, D, 0, 0}; pg8::StaticOrder S; S.init(MROWS, FU, G, bx);
#ifndef X_NO_CONV
            pg8::EpiConv E{kp, l};
            pg8::gemm_phase<pg8::EpiConv, true, pg8::StaticOrder>(lds, lds + XCH_OFF, g, S, E, wave0);
#else
#endif
        }
        GRID_BAR();
        KP_LAUNDER();
        down_phase<l>(kp, lds, wave0);
#if defined(REP_DOWN)
        GRID_BAR(); KP_LAUNDER();
        down_phase<l>(kp, lds, wave0);
#endif
        GRID_BAR();
        KP_LAUNDER();
        {
            PH_IDS();
            float* Y = KOUT() + O_Y; const float* modl = WSP(float, WS_MOD) + (size_t)l * NCB * 6144;
            row_phase<1, false, (l == 1)>(gw, NGW, lane, nullptr, nullptr, Y, WSP(bf16_t, WS_YB), WSP(bf16_t, WS_MBUF), WSP(bf16_t, WS_PART), modl, 5120, KIN(I_FPOSTG) + l * D,
                      WSP(float, WS_MOD) + (size_t)NCB * 6144, 0, 1024, KIN(I_MPREG) + D, l == 0 ? WSP(bf16_t, WS_ABUF2) : nullptr);
        }
}

__device__ __forceinline__ void p0_phase(kp_t kp, LAS unsigned char* lds, const int wave0) {
        PH_IDS();
        LAS float* scr = (LAS float*)(lds + wave * 16384);
        constexpr int I_AD = 16 * 192;
        for (int it = gw; it < 2 * I_AD; it += NGW) {
            int r = it; const int l = r / I_AD; r -= l * I_AD; const int kb = r / 192, nb = r % 192;
            transpose_item(KIN(I_ADAW) + (size_t)l * D * 6144, 6144, 64 * kb, 32 * nb, WSP(bf16_t, WS_ADAT), D, l * 6144 + 32 * nb, scr, lane);
        }
        KP_LAUNDER();
        {
            const float* cpp = KIN(I_CP); const float* csp = KIN(I_CS); bf16_t* AADA = WSP(bf16_t, WS_AADA);
            for (int i = bx * 512 + tid; i < 256 * D / 4; i += G * 512) {
                const int row = i / (D / 4), c = (i % (D / 4)) * 4;
                u32x2 w = (u32x2){0u, 0u};
                if (row < NCB) { const float* cp = row < 8 ? cpp + (size_t)row * D + c : csp + (size_t)(row - 8) * D + c; const f32x4 v = *(const f32x4*)cp;
                    w.x = cvt_pk_bf16(v[0] * sigmoidf_(v[0]), v[1] * sigmoidf_(v[1])); w.y = cvt_pk_bf16(v[2] * sigmoidf_(v[2]), v[3] * sigmoidf_(v[3])); }
                *(u32x2*)(AADA + (size_t)row * D + c) = w;
            }
        }
        KP_LAUNDER();
        {
            const float* xpp = KIN(I_XP); const float* xsp = KIN(I_XS); float* RSTD0 = WSP(float, WS_RSTD0);
            for (int row = gw; row < MROWS; row += NGW) {
                const float* xr = row < NPR ? xpp + (size_t)row * D : xsp + (size_t)(row - NPR) * D;
                float ss = 0.f;
#pragma unroll
                for (int j = 0; j < 4; ++j) { const f32x4 v = *(const f32x4*)(xr + 4 * lane + 256 * j); ss += (v[0] * v[0] + v[1] * v[1]) + (v[2] * v[2] + v[3] * v[3]); }
                ss = wave_sum(ss);
                if (lane == 0) RSTD0[row] = 1.0f / sqrtf(ss * (1.0f / D) + EPS);
            }
        }
        KP_LAUNDER();
        {
            bf16_t* BBT = WSP(bf16_t, WS_BBT); float* LBR = WSP(float, WS_LBR); float* LBI = WSP(float, WS_LBI);
            for (int i = bx * 512 + tid; i < 64 * 64; i += G * 512) {
                const int g = i >> 6;
                const double are = KIN(I_ARE)[i], aim = KIN(I_AIM)[i];
                const double dt = (double)expf(KIN(I_LOGDT)[g]);
                const double mag = exp(are * dt); double sn, cs; sincos_d(aim * dt, sn, cs);
                const double lr = mag * cs, li = mag * sn;
                LBR[i] = (float)lr; LBI[i] = (float)li;
                const double nr = lr - 1.0, ni = li, den = are * are + aim * aim;
                const float fre = (float)((nr * are + ni * aim) / den), fim = (float)((ni * are - nr * aim) / den);
                const float* bre = KIN(I_BRE) + (size_t)i * 16; const float* bim = KIN(I_BIM) + (size_t)i * 16;
                const int p = i & 63;
#pragma unroll
                for (int c = 0; c < 16; c += 2) {
                    const float r0 = fre * bre[c] - fim * bim[c], r1 = fre * bre[c + 1] - fim * bim[c + 1];
                    const float i0 = fre * bim[c] + fim * bre[c], i1 = fre * bim[c + 1] + fim * bre[c + 1];
                    *(unsigned*)(BBT + ((size_t)(g * 128 + p) * 16 + c)) = cvt_pk_bf16(r0, r1);
                    *(unsigned*)(BBT + ((size_t)(g * 128 + 64 + p) * 16 + c)) = cvt_pk_bf16(i0, i1);
                }
            }
        }
        KP_LAUNDER();
        {
            bf16_t* CMT = WSP(bf16_t, WS_CMT); const float* cre = KIN(I_CRE); const float* cim = KIN(I_CIM); const float* sd = KIN(I_SD);
            for (int i = bx * 512 + tid; i < 64 * 16 * 160; i += G * 512) {
                const int k = i % 160, gc = i / 160, c = gc & 15;
                float v = 0.f;
                if (k < 128) v = (k & 1) ? -cim[(size_t)gc * 64 + (k >> 1)] : cre[(size_t)gc * 64 + (k >> 1)];
                else if (k - 128 == c) v = sd[gc];
                CMT[i] = (bf16_t)(cvt_pk_bf16(v, 0.f) & 0xffffu);
            }
        }
}

__device__ __forceinline__ void p1_phase(kp_t kp, LAS unsigned char* lds, const int wave0) {
    {
        PH_IDS();
        constexpr int NADA = 48;
        if (bx < NADA || G <= NADA) {
            pg8::Gemm g{WSP(bf16_t, WS_AADA), WSP(bf16_t, WS_ADAT), D, D, D, 0, 0}; pg8::StaticOrder S; S.init(256, 2 * 6144, G, bx);
            pg8::EpiAda E{kp};
            pg8::gemm_phase<pg8::EpiAda, true, pg8::StaticOrder>(lds, lds + XCH_OFF, g, S, E, wave0);
        }
        if (bx >= NADA || G <= NADA) {
            LAS float* scr = (LAS float*)(lds + wave * 16384);
            constexpr int I_UP = 16 * 176, I_DN = 44 * 32, I_GL = 16 * 32, I_PL = 4 * 8;
            constexpr int NITEMS = 2 * I_UP + 2 * I_DN + 2 * I_GL + 4 * I_PL;
            const int w0 = (G <= NADA) ? bx * 8 + wave : (bx - NADA) * 8 + wave, nw = (G <= NADA) ? G * 8 : (G - NADA) * 8;
            for (int it = w0; it < NITEMS; it += nw) {
                int r = it;
                if (r < 2 * I_UP) { const int l = r / I_UP; r -= l * I_UP; const int kb = r / 176, nb = r % 176; const int n0 = 32 * nb, bj = n0 >= FH, nn = n0 - bj * FH;
                    transpose_item(KIN(I_WUP) + (size_t)l * D * FU, FU, 64 * kb, n0, WSP(bf16_t, WS_WUP) + (size_t)l * FU * D, D, 256 * (nn / 128) + 128 * bj + (nn % 128), scr, lane); continue; }
                r -= 2 * I_UP;
                if (r < 2 * I_DN) { const int l = r / I_DN; r -= l * I_DN; const int kb = r / 32, nb = r % 32;
                    transpose_item(KIN(I_WDN) + (size_t)l * FH * D, D, 64 * kb, 32 * nb, WSP(bf16_t, WS_WDN) + (size_t)l * D * FH, FH, 32 * nb, scr, lane); continue; }
                r -= 2 * I_DN;
                if (r < 2 * I_GL) { const int bj = r / I_GL; r -= bj * I_GL; const int kb = r / 32, nb = r % 32; const int n0 = 32 * nb;
                    transpose_item(KIN(bj ? I_GLUB : I_GLUA), D, 64 * kb, n0, WSP(bf16_t, WS_WGLU), D, 256 * (n0 / 128) + 128 * bj + (n0 % 128), scr, lane); continue; }
                r -= 2 * I_GL;
                { const int g = r / I_PL; r -= g * I_PL; const int kb = r / 8, nb = r % 8;
                    transpose_item(KIN(I_POOLW) + (size_t)g * 256 * 256, 256, 64 * kb, 32 * nb, WSP(bf16_t, WS_WPOOL), 256, g * 256 + 32 * nb, scr, lane); }
            }
        }
    }
}

__device__ __forceinline__ void poolprep_phase(kp_t kp, LAS unsigned char* lds, const int wave0) {
            {
                PH_IDS();
                const int hw = bx * 2 + (tid >> 8), tq = tid & 255, c4 = 4 * tq, wv = tq >> 6;
                const float* xp = KIN(I_XP); const float* xs = KIN(I_XS); const float* spool = KIN(I_SPOOL); const float* g0 = KIN(I_MPREG);
                float* opp = KOUT() + O_POOLP; float* ops = KOUT() + O_POOLS;
                const float* RSTD0 = WSP(float, WS_RSTD0); const float* modl = WSP(float, WS_MOD); bf16_t* ABUF = WSP(bf16_t, WS_ABUF);
                for (int it = hw; it < 512; it += 2 * G) {
                    if (wv == 0) pool_item<2, false>(it, c4, xp, xs, spool, RSTD0, modl, g0, ABUF, opp, ops);
                    else if (wv == 1) pool_item<4, false>(it, c4, xp, xs, spool, RSTD0, modl, g0, ABUF, opp, ops);
                    else if (wv == 2) pool_item<8, false>(it, c4, xp, xs, spool, RSTD0, modl, g0, ABUF, opp, ops);
                    else pool_item<16, false>(it, c4, xp, xs, spool, RSTD0, modl, g0, ABUF, opp, ops);
                }
                for (int is = (2 * G - 1 - hw); is < 128; is += 2 * G) {
                    if (wv == 0) pool_item<2, true>(is, c4, xp, xs, spool, RSTD0, modl, g0, ABUF, opp, ops);
                    else if (wv == 1) pool_item<4, true>(is, c4, xp, xs, spool, RSTD0, modl, g0, ABUF, opp, ops);
                    else if (wv == 2) pool_item<8, true>(is, c4, xp, xs, spool, RSTD0, modl, g0, ABUF, opp, ops);
                    else pool_item<16, true>(is, c4, xp, xs, spool, RSTD0, modl, g0, ABUF, opp, ops);
                }
            }
}

__device__ __forceinline__ void poolgemm_phase(kp_t kp, LAS unsigned char* lds, const int wave0) {
            {
                PH_SC();
                pg8::Gemm g{WSP(bf16_t, WS_ABUF), WSP(bf16_t, WS_WPOOL), 256, D, 256, 256, 0}; pg8::StaticOrder S; S.init(MROWS, D, G, bx);
                pg8::EpiBf16 E{kp, 0};
                pg8::gemm_phase<pg8::EpiBf16, true, pg8::StaticOrder>(lds, lds + XCH_OFF, g, S, E, wave0);
            }
}

__device__ __forceinline__ void s5_phases(kp_t kp, LAS unsigned char* lds, const int wave0) {
                {
                    PH_IDS();
                    LAS float* T = (LAS float*)(lds + wave * S5_WAVE_BYTES);
                    const bf16_t* HB = WSP(bf16_t, WS_ABUF2); bf16_t* GYB = WSP(bf16_t, WS_ABUF);
                    const bf16_t* BBT = WSP(bf16_t, WS_BBT); const bf16_t* CMT = WSP(bf16_t, WS_CMT); const float* LBR = WSP(float, WS_LBR); const float* LBI = WSP(float, WS_LBI);
                    float* CARRY = WSP(float, WS_BND);
                    if (wave < 6) {
                        for (int u = vcu * 6 + wave; u < 512 * 3; u += 6 * G)
                            s5_unit<2>(u, lane, T, HB, GYB, BBT, CMT, LBR, LBI, nullptr, nullptr, nullptr, nullptr, CARRY);
                    } else {
                        for (int u = vcu * 2 + (wave - 6); u < 2048; u += 2 * G)
                            s5_unit<1>(u, lane, T, HB, GYB, BBT, CMT, LBR, LBI, KIN(I_SSRE), KIN(I_SSIM), KOUT() + O_SRES, KOUT() + O_SIMS, nullptr);
                    }
                }
                GRID_BAR();
                KP_LAUNDER();
                {
                    PH_IDS();
                    LAS float* T = (LAS float*)(lds + wave * S5_WAVE_BYTES);
                    const bf16_t* HB = WSP(bf16_t, WS_ABUF2); bf16_t* GYB = WSP(bf16_t, WS_ABUF);
                    const bf16_t* BBT = WSP(bf16_t, WS_BBT); const bf16_t* CMT = WSP(bf16_t, WS_CMT); const float* LBR = WSP(float, WS_LBR); const float* LBI = WSP(float, WS_LBI);
                    float* CARRY = WSP(float, WS_BND);
                    for (int u = gw; u < 512 * 4; u += NGW)
                        s5_unit<0>(u, lane, T, HB, GYB, BBT, CMT, LBR, LBI, nullptr, nullptr, KOUT() + O_SREP, KOUT() + O_SIMP, CARRY);
                }
}

__device__ __forceinline__ void glu_phase(kp_t kp, LAS unsigned char* lds, const int wave0) {
            {
                PH_SC();
                pg8::Gemm g{WSP(bf16_t, WS_ABUF), WSP(bf16_t, WS_WGLU), D, D, D, 0, 0}; pg8::StaticOrder S; S.init(NPR, 2 * D, G, bx);
                pg8::EpiGlu E{kp};
                pg8::gemm_phase<pg8::EpiGlu, true, pg8::StaticOrder>(lds, lds + XCH_OFF, g, S, E, wave0);
            }
            KP_LAUNDER();
            {
                PH_SC();
                pg8::Gemm g{WSP(bf16_t, WS_ABUF), WSP(bf16_t, WS_WGLU), 256, D, D, 0, 256}; pg8::SliceOrder<4, 8> S{bx};
                pg8::EpiBf16 E{kp, 3};
                pg8::gemm_phase<pg8::EpiBf16, true, pg8::SliceOrder<4, 8>>(lds, lds + XCH_OFF, g, S, E, wave0);
            }
}

__device__ __forceinline__ void forward_all(kp_t kp, LAS unsigned char* lds, const int wave0) {
    p0_phase(kp, lds, wave0);
#if defined(REP_P0)
    GRID_BAR(); KP_LAUNDER(); p0_phase(kp, lds, wave0);
#endif
    GRID_BAR();
    if (gridDim.x == 0x7ffffffu) cg::this_grid().sync();
    KP_LAUNDER();
    p1_phase(kp, lds, wave0);
#if defined(REP_P1)
    GRID_BAR(); KP_LAUNDER(); p1_phase(kp, lds, wave0);
#endif
    GRID_BAR(); KP_LAUNDER();
    poolprep_phase(kp, lds, wave0);
#if defined(REP_POOLP)
    GRID_BAR(); KP_LAUNDER(); poolprep_phase(kp, lds, wave0);
#endif
    GRID_BAR(); KP_LAUNDER();
    poolgemm_phase(kp, lds, wave0);
#if defined(REP_POOLG)
    GRID_BAR(); KP_LAUNDER(); poolgemm_phase(kp, lds, wave0);
#endif
    GRID_BAR();
    ffn_block<0>(kp, lds, wave0);
    GRID_BAR(); KP_LAUNDER();
    s5_phases(kp, lds, wave0);
#if defined(REP_S5)
    GRID_BAR(); KP_LAUNDER(); s5_phases(kp, lds, wave0);
#endif
    GRID_BAR(); KP_LAUNDER();
    glu_phase(kp, lds, wave0);
#if defined(REP_GLU)
    GRID_BAR(); KP_LAUNDER(); glu_phase(kp, lds, wave0);
#endif
    GRID_BAR();
    ffn_block<1>(kp, lds, wave0);
}

__global__ void __launch_bounds__(512, 2) mega_fwd(Args a_unused) {
    extern __shared__ __attribute__((aligned(16))) unsigned char lds_raw[];
    LAS unsigned char* lds = (LAS unsigned char*)lds_raw;
    volatile LAS unsigned* MISC = (volatile LAS unsigned*)(lds + MISC_OFF);
    const int tid0 = threadIdx.x;
    const int wave0 = __builtin_amdgcn_readfirstlane(tid0 >> 6);
    kp_t kp = (kp_t)__builtin_amdgcn_kernarg_segment_ptr();
    KP_LAUNDER();
    if (tid0 < 64) MISC[tid0] = 0u;
    __syncthreads();
    (void)xcd_barrier_post((unsigned*)(KWS() + WS_CTL) + CW_BAR, MISC + 8);

    forward_all(kp, lds, wave0);
#ifdef REP_ALL
    GRID_BAR(); KP_LAUNDER();
    forward_all(kp, lds, wave0);
#endif
}

extern "C" void kernel_launch(void* const* d_in, const int* in_sizes, int n_in, void* d_out, int out_size, void* d_ws, size_t ws_size, hipStream_t stream) {
    static int grid = 0;
    if (grid == 0) {
        if (n_in != 30 || ws_size < WS_END) { fprintf(stderr, "kernel_launch: unexpected n_in %d / ws %zu\n", n_in, ws_size); grid = -1; return; }
        int dev = 0, cus = 0, per_cu = 0;
        hipGetDevice(&dev); hipDeviceGetAttribute(&cus, hipDeviceAttributeMultiprocessorCount, dev);
        if (hipFuncSetAttribute((const void*)mega_fwd, hipFuncAttributeMaxDynamicSharedMemorySize, LDS_BYTES) != hipSuccess) { fprintf(stderr, "kernel_launch: hipFuncSetAttribute failed\n"); grid = -1; return; }
        if (hipOccupancyMaxActiveBlocksPerMultiprocessor(&per_cu, (const void*)mega_fwd, 512, LDS_BYTES) != hipSuccess || per_cu < 1) { fprintf(stderr, "kernel_launch: occupancy query %d\n", per_cu); per_cu = 1; }
        (void)hipGetLastError();
        grid = cus;
    }
    if (grid < 0) return;
    hipMemsetAsync((char*)d_ws + WS_CTL, 0, CTL_ZERO_BYTES, stream);
    Args a{};
    for (int i = 0; i < 30; ++i) a.in[i] = (const float*)d_in[i];
    a.out = (float*)d_out; a.ws = (unsigned char*)d_ws;
    void* args[] = {&a};
    hipError_t e = hipLaunchCooperativeKernel((const void*)mega_fwd, dim3(grid), dim3(512), args, LDS_BYTES, stream);
    if (e != hipSuccess) fprintf(stderr, "cooperative launch failed: %s (grid %d)\n", hipGetErrorString(e), grid);
}
```
